# Optimizing an MI355X kernel written in HIP

```python
import math
import jax, jax.numpy as jnp
from jax import lax
import numpy as np

D_MODEL = 2048
BATCH = 4
SEQ = 4096
DEPTH = 2

MIX_WIDTH = D_MODEL
ATTN_WIDTH = MIX_WIDTH // 2
SSM_WIDTH = MIX_WIDTH - ATTN_WIDTH
ATTN_HEAD_DIM = 128
ATTN_HEADS = ATTN_WIDTH // ATTN_HEAD_DIM
MOBA_BLOCK = 256
MOBA_TOPK = 3
Q_CHUNK = 32
SSM_HEAD_DIM = 64
SSM_HEADS = SSM_WIDTH // SSM_HEAD_DIM
SSM_GROUPS = 2
SSM_HEADS_PER_GROUP = SSM_HEADS // SSM_GROUPS
SSM_STATE = 128
SSM_CONV = 4
SSD_CHUNK = 128
XBC_WIDTH = SSM_WIDTH + 2 * SSM_GROUPS * SSM_STATE
IN_COLS = 3 * ATTN_WIDTH + SSM_WIDTH + XBC_WIDTH + SSM_HEADS
SPLIT_POINTS = (ATTN_WIDTH, 2 * ATTN_WIDTH, 3 * ATTN_WIDTH,
                3 * ATTN_WIDTH + SSM_WIDTH, 3 * ATTN_WIDTH + SSM_WIDTH + XBC_WIDTH)
D_FF = 5632
FFN_CONV = 3
EPS = 1e-6

kernel_name = "hymba_moba_ssd_convglu"


def rms_norm(x, w):
    xf = x.astype(jnp.float32)
    y = xf * lax.rsqrt(jnp.mean(xf * xf, axis=-1, keepdims=True) + EPS)
    return (y * w.astype(jnp.float32)).astype(x.dtype)


def causal_dwconv(u, w, bias):
    k_width = w.shape[0]
    s = u.shape[1]
    up = jnp.pad(u, ((0, 0), (k_width - 1, 0), (0, 0)))
    out = bias + up[:, 0:s] * w[0]
    for j in range(1, k_width):
        out = out + up[:, j:j + s] * w[j]
    return out


def moba_attention(q, k, v):
    b, h, s, dh = q.shape
    nb = -(-s // MOBA_BLOCK)
    pad = nb * MOBA_BLOCK - s
    kb = jnp.pad(k, ((0, 0), (0, 0), (0, pad), (0, 0))).reshape(b, h, nb, MOBA_BLOCK, dh)
    vb = jnp.pad(v, ((0, 0), (0, 0), (0, pad), (0, 0))).reshape(b, h, nb, MOBA_BLOCK, dh)
    k_mean = jnp.mean(kb, axis=3)
    n_sel = min(MOBA_TOPK, nb - 1)
    scale = dh ** -0.5
    blk_ids = jnp.arange(nb, dtype=jnp.int32)
    key_off = jnp.arange(MOBA_BLOCK, dtype=jnp.int32)
    gather_blocks = jax.vmap(jax.vmap(lambda blocks, idx: blocks[idx]))
    nq = s // Q_CHUNK
    q_chunks = q.reshape(b, h, nq, Q_CHUNK, dh).transpose(2, 0, 1, 3, 4)

    def chunk_attend(args):
        qc, c = args
        q_pos = c * Q_CHUNK + jnp.arange(Q_CHUNK, dtype=jnp.int32)
        own = (c * Q_CHUNK) // MOBA_BLOCK
        k_own = lax.dynamic_index_in_dim(kb, own, axis=2, keepdims=False)
        v_own = lax.dynamic_index_in_dim(vb, own, axis=2, keepdims=False)
        k_pos = own * MOBA_BLOCK + key_off
        s_own = jnp.einsum('bhqd,bhkd->bhqk', qc, k_own).astype(jnp.float32) * scale
        s_own = jnp.where(k_pos[None, :] <= q_pos[:, None], s_own, -jnp.inf)
        if n_sel == 0:
            p_own = jax.nn.softmax(s_own, axis=-1).astype(v.dtype)
            return jnp.einsum('bhqk,bhkd->bhqd', p_own, v_own)
        gate = jnp.einsum('bhqd,bhnd->bhqn', qc, k_mean).astype(jnp.float32)
        gate = jnp.where(blk_ids < own, gate, -jnp.inf)
        _, sel = lax.top_k(gate, n_sel)
        valid = sel < own
        k_sel = gather_blocks(kb, sel)
        v_sel = gather_blocks(vb, sel)
        s_sel = jnp.einsum('bhqd,bhqjkd->bhqjk', qc, k_sel).astype(jnp.float32) * scale
        s_sel = jnp.where(valid[..., None], s_sel, -jnp.inf).reshape(b, h, Q_CHUNK, n_sel * MOBA_BLOCK)
        p = jax.nn.softmax(jnp.concatenate([s_sel, s_own], axis=-1), axis=-1).astype(v.dtype)
        p_sel = p[..., :n_sel * MOBA_BLOCK].reshape(b, h, Q_CHUNK, n_sel, MOBA_BLOCK)
        p_own = p[..., n_sel * MOBA_BLOCK:]
        return (jnp.einsum('bhqjk,bhqjkd->bhqd', p_sel, v_sel)
                + jnp.einsum('bhqk,bhkd->bhqd', p_own, v_own))

    out = lax.map(chunk_attend, (q_chunks, jnp.arange(nq, dtype=jnp.int32)))
    return out.transpose(1, 2, 0, 3, 4).reshape(b, h, s, dh)


def ssd_chunked_scan(xs, dt, a, bm, cm):
    b, s, g, r, p = xs.shape
    n = bm.shape[-1]
    nc = s // SSD_CHUNK
    L = SSD_CHUNK
    log_a = (dt * a).reshape(b, nc, L, g, r).transpose(0, 3, 4, 1, 2)
    xdt = (xs * dt[..., None]).reshape(b, nc, L, g, r, p)
    bc = bm.reshape(b, nc, L, g, n)
    cc = cm.reshape(b, nc, L, g, n)
    a_cum = jnp.cumsum(log_a, axis=-1)
    tril = jnp.tril(jnp.ones((L, L), dtype=bool))
    seg = a_cum[..., :, None] - a_cum[..., None, :]
    decay = jnp.where(tril, jnp.exp(jnp.where(tril, seg, 0.0)), 0.0)
    cb = jnp.einsum('bclgn,bcsgn->bgcls', cc, bc)
    y_diag = jnp.einsum('bgrcls,bcsgrp->bclgrp', cb[:, :, None] * decay, xdt)
    decay_to_end = jnp.exp(a_cum[..., -1:] - a_cum)
    chunk_states = jnp.einsum('bclgn,bgrcl,bclgrp->cbgrpn', bc, decay_to_end, xdt)
    chunk_decay = jnp.exp(a_cum[..., -1]).transpose(3, 0, 1, 2)

    def carry_state(h, inputs):
        st, dec = inputs
        return h * dec[..., None, None] + st, h

    h0 = jnp.zeros((b, g, r, p, n), xs.dtype)
    _, h_in = lax.scan(carry_state, h0, (chunk_states, chunk_decay))
    y_off = jnp.einsum('bclgn,cbgrpn,bgrcl->bclgrp', cc, h_in, jnp.exp(a_cum))
    return (y_diag + y_off).reshape(b, s, g, r, p)


def hybrid_layer(x, norm1_w, w_in, q_norm_w, k_norm_w, ssm_conv_w, ssm_conv_b, dt_bias, a_log,
                 d_skip, ssm_norm_w, w_out, norm2_w, w_up, ffn_conv_w, ffn_conv_b, w_down):
    b, s, _ = x.shape
    h = rms_norm(x, norm1_w)
    proj = h @ w_in
    q, k, v, z, xbc, dt_raw = jnp.split(proj, SPLIT_POINTS, axis=-1)

    q = rms_norm(q.reshape(b, s, ATTN_HEADS, ATTN_HEAD_DIM), q_norm_w).transpose(0, 2, 1, 3)
    k = rms_norm(k.reshape(b, s, ATTN_HEADS, ATTN_HEAD_DIM), k_norm_w).transpose(0, 2, 1, 3)
    v = v.reshape(b, s, ATTN_HEADS, ATTN_HEAD_DIM).transpose(0, 2, 1, 3)
    attn = moba_attention(q, k, v).transpose(0, 2, 1, 3).reshape(b, s, ATTN_WIDTH)

    xbc = jax.nn.silu(causal_dwconv(xbc, ssm_conv_w, ssm_conv_b))
    xs, bm, cm = jnp.split(xbc, (SSM_WIDTH, SSM_WIDTH + SSM_GROUPS * SSM_STATE), axis=-1)
    xs = xs.astype(jnp.float32).reshape(b, s, SSM_GROUPS, SSM_HEADS_PER_GROUP, SSM_HEAD_DIM)
    bm = bm.astype(jnp.float32).reshape(b, s, SSM_GROUPS, SSM_STATE)
    cm = cm.astype(jnp.float32).reshape(b, s, SSM_GROUPS, SSM_STATE)
    dt = jax.nn.softplus(dt_raw.astype(jnp.float32) + dt_bias.astype(jnp.float32))
    dt = dt.reshape(b, s, SSM_GROUPS, SSM_HEADS_PER_GROUP)
    a = -jnp.exp(a_log.astype(jnp.float32)).reshape(SSM_GROUPS, SSM_HEADS_PER_GROUP)
    y = ssd_chunked_scan(xs, dt, a, bm, cm)
    y = y + d_skip.astype(jnp.float32).reshape(SSM_GROUPS, SSM_HEADS_PER_GROUP)[:, :, None] * xs
    gate = jax.nn.silu(z.astype(jnp.float32)).reshape(b, s, SSM_GROUPS, SSM_HEADS_PER_GROUP * SSM_HEAD_DIM)
    y = y.reshape(b, s, SSM_GROUPS, SSM_HEADS_PER_GROUP * SSM_HEAD_DIM) * gate
    y = rms_norm(y, ssm_norm_w.reshape(SSM_GROUPS, SSM_HEADS_PER_GROUP * SSM_HEAD_DIM))
    ssm = y.reshape(b, s, SSM_WIDTH).astype(x.dtype)

    x = x + jnp.concatenate([attn, ssm], axis=-1) @ w_out

    h = rms_norm(x, norm2_w)
    u = causal_dwconv(h @ w_up, ffn_conv_w, ffn_conv_b)
    u_gate, u_val = jnp.split(u, 2, axis=-1)
    return x + (jax.nn.silu(u_gate) * u_val) @ w_down


def setup_inputs(seed: int = 0) -> dict:
    key = jax.random.key(seed)
    ks = jax.random.split(key, 17)

    def nrm(k, shape, scale):
        return jax.random.normal(k, shape, jnp.float32) * scale

    x = nrm(ks[0], (BATCH, SEQ, D_MODEL), 1.0)
    norm1_w = 1.0 + nrm(ks[1], (DEPTH, D_MODEL), 0.02)
    w_in = nrm(ks[2], (DEPTH, D_MODEL, IN_COLS), D_MODEL ** -0.5)
    q_norm_w = 1.0 + nrm(ks[3], (DEPTH, ATTN_HEAD_DIM), 0.02)
    k_norm_w = 1.0 + nrm(ks[4], (DEPTH, ATTN_HEAD_DIM), 0.02)
    ssm_conv_w = nrm(ks[5], (DEPTH, SSM_CONV, XBC_WIDTH), SSM_CONV ** -0.5)
    ssm_conv_b = nrm(ks[6], (DEPTH, XBC_WIDTH), 0.02)
    dt0 = jnp.exp(jax.random.uniform(ks[7], (DEPTH, SSM_HEADS), jnp.float32,
                                     minval=math.log(1e-3), maxval=math.log(1e-1)))
    dt_bias = dt0 + jnp.log(-jnp.expm1(-dt0))
    a_log = jnp.log(jax.random.uniform(ks[8], (DEPTH, SSM_HEADS), jnp.float32, minval=1.0, maxval=16.0))
    d_skip = 1.0 + nrm(ks[9], (DEPTH, SSM_HEADS), 0.1)
    ssm_norm_w = 1.0 + nrm(ks[10], (DEPTH, SSM_WIDTH), 0.02)
    w_out = nrm(ks[11], (DEPTH, MIX_WIDTH, D_MODEL), MIX_WIDTH ** -0.5)
    norm2_w = 1.0 + nrm(ks[12], (DEPTH, D_MODEL), 0.02)
    w_up = nrm(ks[13], (DEPTH, D_MODEL, 2 * D_FF), D_MODEL ** -0.5)
    ffn_conv_w = nrm(ks[14], (DEPTH, FFN_CONV, 2 * D_FF), FFN_CONV ** -0.5)
    ffn_conv_b = nrm(ks[15], (DEPTH, 2 * D_FF), 0.02)
    w_down = nrm(ks[16], (DEPTH, D_FF, D_MODEL), D_FF ** -0.5)
    return {"x": x, "norm1_w": norm1_w, "w_in": w_in, "q_norm_w": q_norm_w, "k_norm_w": k_norm_w,
            "ssm_conv_w": ssm_conv_w, "ssm_conv_b": ssm_conv_b, "dt_bias": dt_bias, "a_log": a_log,
            "d_skip": d_skip, "ssm_norm_w": ssm_norm_w, "w_out": w_out, "norm2_w": norm2_w,
            "w_up": w_up, "ffn_conv_w": ffn_conv_w, "ffn_conv_b": ffn_conv_b, "w_down": w_down}


def reference(x, norm1_w, w_in, q_norm_w, k_norm_w, ssm_conv_w, ssm_conv_b, dt_bias, a_log,
              d_skip, ssm_norm_w, w_out, norm2_w, w_up, ffn_conv_w, ffn_conv_b, w_down):
    for i in range(DEPTH):
        x = hybrid_layer(x, norm1_w[i], w_in[i], q_norm_w[i], k_norm_w[i], ssm_conv_w[i],
                         ssm_conv_b[i], dt_bias[i], a_log[i], d_skip[i], ssm_norm_w[i], w_out[i],
                         norm2_w[i], w_up[i], ffn_conv_w[i], ffn_conv_b[i], w_down[i])
    return x
```

```cpp
#include <hip/hip_runtime.h>
#include <hip/hip_cooperative_groups.h>
#include <cstdio>
#include <cstdint>
namespace cg = cooperative_groups;

namespace pg8 {
#define PG8_LAS __attribute__((address_space(3)))
typedef unsigned short bf16_t;
typedef short bf16x8 __attribute__((ext_vector_type(8)));
typedef float f32x4 __attribute__((ext_vector_type(4)));
typedef unsigned u32x4 __attribute__((ext_vector_type(4)));
constexpr int BM = 256, BK = 64, HALF = 128, HTB = HALF * BK * 2  , STAGE_BYTES = 8 * HTB, NXCD = 8, WGM = 8;

__host__ __device__ __forceinline__ int lds_byte(int r, int c) { const int st = (r >> 4) * 2 + (c >> 5), rr = r & 15, cc = c & 31, ob = rr * 64 + cc * 2; return st * 1024 + (ob ^ (((ob >> 9) & 1) << 5)); }
__host__ __device__ __forceinline__ void stage_rc(int b, int& R, int& C) { const int st = b / 1024, sb = b % 1024, swz = sb ^ (((sb >> 9) & 1) << 5); R = (st >> 1) * 16 + swz / 64; C = (st & 1) * 32 + (swz % 64) / 2; }
__host__ __device__ __forceinline__ int perm32(int rho) { const int n = rho >> 4, i = rho & 15; return 8 * (i >> 2) + 4 * n + (i & 3); }

struct Unit { int pm, pn, kind; };
struct Gemm { const bf16_t *A0, *A1, *B0, *B1; int K; };

__device__ __forceinline__ void tile_map(int L, int nM, int nN, int& pm, int& pn) {
    const int nwg = nM * nN; int wgid = L;
    { const int q = nwg / NXCD, r = nwg % NXCD, xcd = wgid % NXCD, off = wgid / NXCD; wgid = (xcd < r ? xcd * (q + 1) : r * (q + 1) + (xcd - r) * q) + off; }
    const int nig = WGM * nN, gid = wgid / nig, fm = gid * WGM, gsz = (nM - fm) < WGM ? (nM - fm) : WGM;
    pm = fm + ((wgid % nig) % gsz); pn = (wgid % nig) / gsz;
}
struct DualOrder {
    int nM0, nN0, nM1, nN1, G, c;
    __device__ __forceinline__ bool next(int i, Unit& u) const {
        const int L = i * G + c; const int n0 = nM0 * nN0, n1 = nM1 * nN1;
        if (L < n0) { tile_map(L, nM0, nN0, u.pm, u.pn); u.kind = 0; return true; }
        if (L < n0 + n1) { tile_map(L - n0, nM1, nN1, u.pm, u.pn); u.kind = 1; return true; }
        return false;
    }
    __device__ __forceinline__ void a_ready(const Unit&) const {}
    __device__ __forceinline__ void done(const Unit&) const {}
};

__device__ __forceinline__ unsigned cvt_pk_bf16(float lo, float hi) { unsigned r; asm volatile("v_cvt_pk_bf16_f32 %0, %1, %2" : "=v"(r) : "v"(lo), "v"(hi)); return r; }

constexpr float RMS_EPS = 1e-6f;
struct EpiScale {
    static constexpr bool PERM = true, AFTER_DRAIN = false;
    bf16_t* O0; int ld0; bf16_t* O1; int ld1; const float* ss; float invn;
    __device__ __forceinline__ void operator()(const f32x4 (&acc)[2][2][4][2], const Unit& u, int wr, int wc, int fr, int fq) const {
        const int row0 = u.pm * BM + wr * 64 + fr, col0 = u.pn * BM + wc * 32 + 8 * fq;
        if (u.kind == 0) {
#pragma unroll
            for (int ai = 0; ai < 2; ++ai)
#pragma unroll
                for (int m = 0; m < 4; ++m) { const int r = row0 + ai * HALF + m * 16; const float rs = __builtin_amdgcn_rsqf(ss[r] * invn + RMS_EPS);
                    bf16_t* rowp = O0 + (size_t)r * ld0 + col0;
#pragma unroll
                    for (int bj = 0; bj < 2; ++bj) { const f32x4 v0 = acc[ai][bj][m][0] * rs, v1 = acc[ai][bj][m][1] * rs;
                        u32x4 w; w.x = cvt_pk_bf16(v0[0], v0[1]); w.y = cvt_pk_bf16(v0[2], v0[3]); w.z = cvt_pk_bf16(v1[0], v1[1]); w.w = cvt_pk_bf16(v1[2], v1[3]);
                        *(u32x4*)(rowp + bj * HALF) = w; } }
        } else {
            f32x4 rsv[2][2];
#pragma unroll
            for (int bj = 0; bj < 2; ++bj)
#pragma unroll
                for (int n = 0; n < 2; ++n) { const f32x4 s4 = *(const f32x4*)(ss + col0 + bj * HALF + 4 * n);
#pragma unroll
                    for (int e = 0; e < 4; ++e) rsv[bj][n][e] = __builtin_amdgcn_rsqf(s4[e] * invn + RMS_EPS); }
#pragma unroll
            for (int ai = 0; ai < 2; ++ai)
#pragma unroll
                for (int m = 0; m < 4; ++m) { const int r = row0 + ai * HALF + m * 16; bf16_t* rowp = O1 + (size_t)r * ld1 + col0;
#pragma unroll
                    for (int bj = 0; bj < 2; ++bj) { const f32x4 v0 = acc[ai][bj][m][0] * rsv[bj][0], v1 = acc[ai][bj][m][1] * rsv[bj][1];
                        u32x4 w; w.x = cvt_pk_bf16(v0[0], v0[1]); w.y = cvt_pk_bf16(v0[2], v0[3]); w.z = cvt_pk_bf16(v1[0], v1[1]); w.w = cvt_pk_bf16(v1[2], v1[3]);
                        *(u32x4*)(rowp + bj * HALF) = w; } }
        }
    }
};
struct EpiResid {
    static constexpr bool PERM = true, AFTER_DRAIN = false;
    const float* xold; float* xnew; bf16_t* xb; float* ssout;
    __device__ __forceinline__ void operator()(const f32x4 (&acc)[2][2][4][2], const Unit& u, int wr, int wc, int fr, int fq) const {
        const int row0 = u.pm * BM + wr * 64 + fr, col0 = u.pn * BM + wc * 32 + 8 * fq;
#pragma unroll
        for (int ai = 0; ai < 2; ++ai)
#pragma unroll
            for (int m = 0; m < 4; ++m) { const int r = row0 + ai * HALF + m * 16; const size_t off = (size_t)r * 2048 + col0; float part = 0.f;
#pragma unroll
                for (int bj = 0; bj < 2; ++bj) { const f32x4 o0 = *(const f32x4*)(xold + off + bj * HALF), o1 = *(const f32x4*)(xold + off + bj * HALF + 4);
                    const f32x4 v0 = o0 + acc[ai][bj][m][0], v1 = o1 + acc[ai][bj][m][1];
                    *(f32x4*)(xnew + off + bj * HALF) = v0; *(f32x4*)(xnew + off + bj * HALF + 4) = v1;
                    u32x4 w; w.x = cvt_pk_bf16(v0[0], v0[1]); w.y = cvt_pk_bf16(v0[2], v0[3]); w.z = cvt_pk_bf16(v1[0], v1[1]); w.w = cvt_pk_bf16(v1[2], v1[3]);
                    *(u32x4*)(xb + off + bj * HALF) = w;
                    part += (v0[0] * v0[0] + v0[1] * v0[1]) + (v0[2] * v0[2] + v0[3] * v0[3]) + (v1[0] * v1[0] + v1[1] * v1[1]) + (v1[2] * v1[2] + v1[3] * v1[3]); }
                part += __shfl_xor(part, 16); part += __shfl_xor(part, 32);
                if (ssout != nullptr && fq == 0) atomicAdd(ssout + r, part); }
    }
};

template <class Epi, class Sched, bool ALIGN_EPI = false, bool SP2 = false>
__device__ __forceinline__ void gemm_phase(PG8_LAS unsigned char* lds, const Gemm g, const Sched& S, const Epi& E) {
    int tid = threadIdx.x; asm volatile("" : "+v"(tid)); const int wid = __builtin_amdgcn_readfirstlane(tid >> 6), lane = tid & 63, wr = wid >> 2, wc = wid & 3, fr = lane & 15, fq = lane >> 4;
    int K = g.K; asm volatile("" : "+s"(K)); const int nt = K / BK;
    unsigned voffA[2], voffB[2];
#pragma unroll
    for (int i = 0; i < 2; ++i) { int R, C; stage_rc(tid * 16 + i * 8192, R, C); const int Rb = Epi::PERM ? ((R & ~31) + perm32(R & 31)) : R;
        voffA[i] = (unsigned)(R * K + C) * 2u; voffB[i] = (unsigned)(Rb * K + C) * 2u; }
    const size_t kstep = (size_t)(BK * 2);
    const size_t hstep = (size_t)HALF * K * 2;
    const size_t tstep = 2 * hstep;
    const unsigned ldsw = (unsigned)wid * 1024u;
    const int aoff = lds_byte(wr * 64 + fr, fq * 8), boff = lds_byte(wc * 32 + fr, fq * 8);
#define PG8_SA(b, h) (((b) * 2 + (h)) * HTB)
#define PG8_SB(b, h) ((4 + (b) * 2 + (h)) * HTB)
#define PG8_STAGE(bufoff, gbase, voff) do { _Pragma("unroll") for (int _i = 0; _i < 2; ++_i) \
        __builtin_amdgcn_global_load_lds((const unsigned*)((const char*)(gbase) + (voff)[_i]), (PG8_LAS unsigned*)(lds + (bufoff) + ldsw + _i * 8192), 16, 0, 0); } while (0)
#define PG8_LDA(dst, b, h) do { _Pragma("unroll") for (int m = 0; m < 4; ++m) _Pragma("unroll") for (int k = 0; k < 2; ++k) dst[m][k] = *(const PG8_LAS bf16x8*)(lds + PG8_SA(b, h) + aoff + m * 2048 + k * 1024); } while (0)
#define PG8_LDB(dst, b, h) do { _Pragma("unroll") for (int n = 0; n < 2; ++n) _Pragma("unroll") for (int k = 0; k < 2; ++k) dst[n][k] = *(const PG8_LAS bf16x8*)(lds + PG8_SB(b, h) + boff + n * 2048 + k * 1024); } while (0)
#define PG8_MMA(ai, bj, At, Bt) do { __builtin_amdgcn_s_setprio(1); _Pragma("unroll") for (int m = 0; m < 4; ++m) _Pragma("unroll") for (int n = 0; n < 2; ++n) _Pragma("unroll") for (int k = 0; k < 2; ++k) \
        acc[ai][bj][m][n] = __builtin_amdgcn_mfma_f32_16x16x32_bf16(Bt[n][k], At[m][k], acc[ai][bj][m][n], 0, 0, 0); __builtin_amdgcn_s_setprio(0); } while (0)
#define PG8_WAIT_V(n) asm volatile("s_waitcnt vmcnt(" #n ")" ::: "memory")
#define PG8_WAIT_L(n) asm volatile("s_waitcnt lgkmcnt(" #n ")" ::: "memory")
#define PG8_BAR __builtin_amdgcn_s_barrier()
#define PG8_SCHED __builtin_amdgcn_sched_barrier(0)
    Unit cur, nxt; int ui = 0;
    if (!S.next(0, cur)) return;
    f32x4 acc[2][2][4][2];
#pragma unroll
    for (int a = 0; a < 2; ++a)
#pragma unroll
        for (int b = 0; b < 2; ++b)
#pragma unroll
            for (int m = 0; m < 4; ++m)
#pragma unroll
                for (int n = 0; n < 2; ++n) acc[a][b][m][n] = (f32x4){0.f, 0.f, 0.f, 0.f};
    bf16x8 At[4][2], B0[2][2], B1[2][2];
    const char* cA = (const char*)(cur.kind ? g.A1 : g.A0) + (size_t)cur.pm * tstep; const char* cB = (const char*)(cur.kind ? g.B1 : g.B0) + (size_t)cur.pn * tstep;
    S.a_ready(cur);
    if constexpr (SP2) {
        PG8_STAGE(PG8_SB(0, 0), cB, voffB); PG8_STAGE(PG8_SB(0, 1), cB + hstep, voffB); PG8_STAGE(PG8_SA(0, 0), cA, voffA); PG8_STAGE(PG8_SA(0, 1), cA + hstep, voffA);
        if (wr == 1) PG8_BAR;
        PG8_WAIT_V(2); PG8_BAR;
        PG8_STAGE(PG8_SB(1, 0), cB + kstep, voffB); PG8_STAGE(PG8_SA(1, 0), cA + kstep, voffA); PG8_STAGE(PG8_SB(1, 1), cB + hstep + kstep, voffB);
        PG8_WAIT_V(6); PG8_BAR;
    } else {
        PG8_STAGE(PG8_SB(0, 0), cB, voffB); PG8_STAGE(PG8_SA(0, 0), cA, voffA); PG8_STAGE(PG8_SB(0, 1), cB + hstep, voffB); PG8_STAGE(PG8_SA(0, 1), cA + hstep, voffA);
        if (wr == 1) PG8_BAR;
        PG8_WAIT_V(4); PG8_BAR;
        PG8_STAGE(PG8_SB(1, 0), cB + kstep, voffB); PG8_STAGE(PG8_SA(1, 0), cA + kstep, voffA); PG8_STAGE(PG8_SB(1, 1), cB + hstep + kstep, voffB);
        PG8_WAIT_V(6); PG8_BAR;
    }
    for (;;) {
        const bool has_next = S.next(ui + 1, nxt);
        const char* nA = has_next ? (const char*)(nxt.kind ? g.A1 : g.A0) + (size_t)nxt.pm * tstep : cA; const char* nB = has_next ? (const char*)(nxt.kind ? g.B1 : g.B0) + (size_t)nxt.pn * tstep : cB;
        for (int t = 0; t < nt; t += 2) {
            const bool last = (t == nt - 2);
            const char* a1 = cA + (size_t)(t + 1) * kstep;
            const char* a2 = last ? nA : cA + (size_t)(t + 2) * kstep; const char* b2 = last ? nB : cB + (size_t)(t + 2) * kstep;
            const char* a3 = a2 + kstep; const char* b3 = b2 + kstep;
            if (last && has_next) S.a_ready(nxt);
            if constexpr (SP2) {
            PG8_LDB(B0, 0, 0); PG8_LDB(B1, 0, 1); PG8_SCHED; PG8_LDA(At, 0, 0); PG8_STAGE(PG8_SA(1, 1), a1 + hstep, voffA);
            PG8_WAIT_V(8); PG8_WAIT_L(0); PG8_BAR; PG8_MMA(0, 0, At, B0); PG8_MMA(0, 1, At, B1); PG8_BAR; PG8_SCHED;
            PG8_LDA(At, 0, 1); PG8_STAGE(PG8_SB(0, 0), b2, voffB); PG8_STAGE(PG8_SB(0, 1), b2 + hstep, voffB); PG8_STAGE(PG8_SA(0, 0), a2, voffA);
            PG8_WAIT_V(8); PG8_WAIT_L(0); PG8_BAR; PG8_MMA(1, 0, At, B0); PG8_MMA(1, 1, At, B1); PG8_BAR; PG8_SCHED;
            PG8_LDB(B0, 1, 0); PG8_LDB(B1, 1, 1); PG8_SCHED; PG8_LDA(At, 1, 0); PG8_STAGE(PG8_SA(0, 1), a2 + hstep, voffA);
            PG8_WAIT_V(8); PG8_WAIT_L(0); PG8_BAR; PG8_MMA(0, 0, At, B0); PG8_MMA(0, 1, At, B1); PG8_BAR; PG8_SCHED;
            PG8_LDA(At, 1, 1); PG8_STAGE(PG8_SB(1, 0), b3, voffB); PG8_STAGE(PG8_SB(1, 1), b3 + hstep, voffB); PG8_STAGE(PG8_SA(1, 0), a3, voffA);
            PG8_WAIT_V(8); PG8_WAIT_L(0); PG8_BAR; PG8_MMA(1, 0, At, B0); PG8_MMA(1, 1, At, B1); PG8_BAR; PG8_SCHED;
            } else {
            PG8_LDB(B0, 0, 0); PG8_SCHED; PG8_LDA(At, 0, 0); PG8_STAGE(PG8_SA(1, 1), a1 + hstep, voffA);
            PG8_WAIT_L(8); PG8_BAR; PG8_WAIT_L(0); PG8_MMA(0, 0, At, B0); PG8_BAR; PG8_SCHED;
            PG8_LDB(B1, 0, 1); PG8_STAGE(PG8_SB(0, 0), b2, voffB);
            PG8_BAR; PG8_WAIT_L(0); PG8_MMA(0, 1, At, B1); PG8_BAR;
            PG8_LDA(At, 0, 1); PG8_STAGE(PG8_SA(0, 0), a2, voffA);
            PG8_BAR; PG8_WAIT_L(0); PG8_MMA(1, 0, At, B0); PG8_BAR; PG8_SCHED;
            PG8_STAGE(PG8_SB(0, 1), b2 + hstep, voffB);
            PG8_WAIT_V(6); PG8_BAR; PG8_MMA(1, 1, At, B1); PG8_BAR;
            PG8_LDB(B0, 1, 0); PG8_SCHED; PG8_LDA(At, 1, 0); PG8_STAGE(PG8_SA(0, 1), a2 + hstep, voffA);
            PG8_WAIT_L(8); PG8_BAR; PG8_WAIT_L(0); PG8_MMA(0, 0, At, B0); PG8_BAR; PG8_SCHED;
            PG8_LDB(B1, 1, 1); PG8_STAGE(PG8_SB(1, 0), b3, voffB);
            PG8_BAR; PG8_WAIT_L(0); PG8_MMA(0, 1, At, B1); PG8_BAR;
            PG8_LDA(At, 1, 1); PG8_STAGE(PG8_SA(1, 0), a3, voffA);
            PG8_BAR; PG8_WAIT_L(0); PG8_MMA(1, 0, At, B0); PG8_BAR; PG8_SCHED;
            PG8_STAGE(PG8_SB(1, 1), b3 + hstep, voffB);
            PG8_WAIT_V(6); PG8_BAR; PG8_MMA(1, 1, At, B1); PG8_BAR;
            }
        }
        if constexpr (ALIGN_EPI) { if (wr == 0) PG8_BAR; }
        if constexpr (!Epi::AFTER_DRAIN) { E(acc, cur, wr, wc, fr, fq); S.done(cur); }
        if (!has_next) break;
#pragma unroll
        for (int a = 0; a < 2; ++a)
#pragma unroll
            for (int b = 0; b < 2; ++b)
#pragma unroll
                for (int m = 0; m < 4; ++m)
#pragma unroll
                    for (int n = 0; n < 2; ++n) acc[a][b][m][n] = (f32x4){0.f, 0.f, 0.f, 0.f};
        cur = nxt; cA = nA; cB = nB; ++ui;
        if constexpr (ALIGN_EPI) { if (wr == 1) PG8_BAR; }
    }
    PG8_WAIT_V(0);
    if constexpr (!ALIGN_EPI) { if (wr == 0) PG8_BAR; }
    PG8_BAR;
    if constexpr (Epi::AFTER_DRAIN) { E.fused(acc, cur, wr, wc, fr, fq, lds, wid, lane); S.done(cur); }
#undef PG8_SA
#undef PG8_SB
#undef PG8_STAGE
#undef PG8_LDA
#undef PG8_LDB
#undef PG8_MMA
#undef PG8_WAIT_V
#undef PG8_WAIT_L
#undef PG8_BAR
#undef PG8_SCHED
}
}

#define LAS __attribute__((address_space(3)))
typedef unsigned short bf16;
typedef unsigned v4u __attribute__((ext_vector_type(4)));
typedef unsigned v2u __attribute__((ext_vector_type(2)));
typedef float f32x4 __attribute__((ext_vector_type(4)));
typedef float f32x2 __attribute__((ext_vector_type(2)));
typedef short bf16x8 __attribute__((ext_vector_type(8)));

constexpr int T = 16384, SEQ = 4096, DM = 2048, NPT = 3840, NCT = 2304, NCC = 1280, DFF = 5632, NUP = 11264, INC = 5648;
constexpr float EPS = 1e-6f;
constexpr int PT_Q = 0, PT_K = 1024, PT_Z = 2048, PT_BM = 3072, PT_CM = 3328, PT_DT = 3584;
constexpr size_t SZ_WA = (size_t)NPT * DM * 2, SZ_WB = (size_t)NCT * DM * 2, SZ_WOUT = (size_t)DM * DM * 2, SZ_WUP = (size_t)NUP * DM * 2, SZ_WDOWN = (size_t)DM * DFF * 2;
constexpr size_t OFF_WA = 0, OFF_WB = OFF_WA + SZ_WA, OFF_WOUT = OFF_WB + SZ_WB, OFF_WUP = OFF_WOUT + SZ_WOUT, OFF_WDOWN = OFF_WUP + SZ_WUP;
constexpr size_t OFF_XB = OFF_WDOWN + SZ_WDOWN;
constexpr size_t OFF_SMALL = OFF_XB + (size_t)T * DM * 2;
constexpr size_t OFF_DT = OFF_SMALL, OFF_ACUM = OFF_DT + (1u << 20), OFF_CDEC = OFF_ACUM + (1u << 20), OFF_KMEAN = OFF_CDEC + 65536, OFF_SS = OFF_KMEAN + 262144;
constexpr size_t OFF_BIG = OFF_SMALL + (4u << 20);
constexpr size_t OFF_PT = OFF_BIG, OFF_CT = OFF_PT + (size_t)T * NPT * 2, OFF_CC = OFF_CT + (size_t)NCT * T * 2, OFF_BMCM = OFF_CC + (size_t)NCC * T * 2;
constexpr size_t OFF_MIX = OFF_BMCM + (size_t)T * 512 * 2, OFF_STATES = OFF_MIX + (size_t)T * DM * 2, OFF_HIN = OFF_STATES + (size_t)2048 * 8192 * 4, OFF_END1 = OFF_HIN + (size_t)2048 * 8192 * 2;
constexpr size_t OFF_U = OFF_BIG, OFF_G = OFF_U + (size_t)T * NUP * 2, OFF_END2 = OFF_G + (size_t)T * DFF * 2;
constexpr size_t WS_NEED = OFF_END2 > OFF_END1 ? OFF_END2 : OFF_END1;
static_assert(WS_NEED <= 738197504ull, "workspace");
static_assert(OFF_SS + 4 * T * 4 <= OFF_BIG, "small region");
constexpr int LDS_BYTES = 147456;

struct Params { const float* in[17]; float* out; unsigned char* ws; };

__device__ __forceinline__ float bflo(unsigned u) { return __uint_as_float(u << 16); }
__device__ __forceinline__ float bfhi(unsigned u) { return __uint_as_float(u & 0xffff0000u); }
__device__ __forceinline__ float bf1(bf16 b) { return __uint_as_float(((unsigned)b) << 16); }
__device__ __forceinline__ unsigned pk2(float lo, float hi) { return pg8::cvt_pk_bf16(lo, hi); }
__device__ __forceinline__ float silu_f(float x) { return x / (1.f + __expf(-x)); }
__device__ __forceinline__ float wave_sum(float v) {
#pragma unroll
    for (int o = 1; o < 64; o <<= 1) v += __shfl_xor(v, o);
    return v;
}
__device__ __forceinline__ float wave_max(float v) {
#pragma unroll
    for (int o = 1; o < 64; o <<= 1) v = fmaxf(v, __shfl_xor(v, o));
    return v;
}
__device__ __forceinline__ int fresh_tid() { int t = threadIdx.x; asm volatile("" : "+v"(t)); return t; }
__device__ __forceinline__ int fresh_bid() { int t = blockIdx.x; asm volatile("" : "+s"(t)); return t; }
#define MFMA16(a, b, c) __builtin_amdgcn_mfma_f32_16x16x32_bf16((a), (b), (c), 0, 0, 0)

__device__ __forceinline__ void transpose_item(const float* W, int N, int ncol0, int nvalid, const float* kscale, bf16* WT, int K, int kb, int nb, LAS float* scr, int lane) {
    const int k0 = 64 * kb, n0 = 32 * nb, j = lane & 31; const bool ok = (n0 + j) < nvalid;
#pragma unroll 8
    for (int i = 0; i < 32; ++i) { const int kk = 2 * i + (lane >> 5); float v = 0.f;
        if (ok) { v = W[(size_t)(k0 + kk) * N + ncol0 + n0 + j]; if (kscale) v *= kscale[k0 + kk]; }
        scr[kk * 33 + j] = v; }
    asm volatile("s_waitcnt lgkmcnt(0)" ::: "memory");
    const int c = lane & 7;
#pragma unroll
    for (int jj = 0; jj < 4; ++jj) { const int n = (lane >> 3) + 8 * jj; const LAS float* s = scr + (8 * c) * 33 + n;
        v4u o; o.x = pk2(s[0 * 33], s[1 * 33]); o.y = pk2(s[2 * 33], s[3 * 33]); o.z = pk2(s[4 * 33], s[5 * 33]); o.w = pk2(s[6 * 33], s[7 * 33]);
        *(v4u*)(WT + (size_t)(n0 + n) * K + k0 + 8 * c) = o; }
    asm volatile("s_waitcnt lgkmcnt(0)" ::: "memory");
}
__device__ __forceinline__ void convert_jobs(const Params& P, int layer, int jlo, int jhi, LAS unsigned char* lds) {
    unsigned char* ws = P.ws; const int tid_ = fresh_tid(); const int lane = tid_ & 63, wave_ = __builtin_amdgcn_readfirstlane(tid_ >> 6); const int gw = fresh_bid() * 8 + wave_, NGW = gridDim.x * 8; LAS float* scr = (LAS float*)lds + wave_ * (64 * 33);
    const float* w_in = P.in[2] + (size_t)layer * DM * INC; const float* n1 = P.in[1] + layer * DM; const float* n2 = P.in[12] + layer * DM;
    for (int j = jlo; j < jhi; ++j) {
        const float* W; int N, ncol0, nvalid, nrows, K; const float* ks; bf16* dst;
        if (j == 0)      { W = w_in; N = INC; ncol0 = 0;    nvalid = 2048; nrows = 2048; K = DM; ks = n1; dst = (bf16*)(ws + OFF_WA); }
        else if (j == 1) { W = w_in; N = INC; ncol0 = 3072; nvalid = 1024; nrows = 1024; K = DM; ks = n1; dst = (bf16*)(ws + OFF_WA) + (size_t)2048 * DM; }
        else if (j == 2) { W = w_in; N = INC; ncol0 = 5120; nvalid = 528;  nrows = 768;  K = DM; ks = n1; dst = (bf16*)(ws + OFF_WA) + (size_t)3072 * DM; }
        else if (j == 3) { W = w_in; N = INC; ncol0 = 2048; nvalid = 1024; nrows = 1024; K = DM; ks = n1; dst = (bf16*)(ws + OFF_WB); }
        else if (j == 4) { W = w_in; N = INC; ncol0 = 4096; nvalid = 1280; nrows = 1280; K = DM; ks = n1; dst = (bf16*)(ws + OFF_WB) + (size_t)1024 * DM; }
        else if (j == 5) { W = P.in[11] + (size_t)layer * DM * DM; N = DM; ncol0 = 0; nvalid = DM; nrows = DM; K = DM; ks = nullptr; dst = (bf16*)(ws + OFF_WOUT); }
        else if (j == 6) { W = P.in[13] + (size_t)layer * DM * NUP; N = NUP; ncol0 = 0; nvalid = NUP; nrows = NUP; K = DM; ks = n2; dst = (bf16*)(ws + OFF_WUP); }
        else             { W = P.in[16] + (size_t)layer * DFF * DM; N = DM; ncol0 = 0; nvalid = DM; nrows = DM; K = DFF; ks = nullptr; dst = (bf16*)(ws + OFF_WDOWN); }
        const int nnb = nrows / 32, nitems = (K / 64) * nnb;
        for (int it = gw; it < nitems; it += NGW) transpose_item(W, N, ncol0, nvalid, ks, dst, K, it / nnb, it % nnb, scr, lane);
    }
}

__device__ __forceinline__ void phase_x0(const Params& P) {
    const int tid_ = fresh_tid(); const int lane = tid_ & 63; const int gw = fresh_bid() * 8 + __builtin_amdgcn_readfirstlane(tid_ >> 6), NGW = gridDim.x * 8;
    const float* x = P.in[0]; bf16* xb = (bf16*)(P.ws + OFF_XB); float* ss = (float*)(P.ws + OFF_SS);
    for (int m = gw; m < T; m += NGW) {
        const f32x4* xr = (const f32x4*)(x + (size_t)m * DM) + lane; v2u* o = (v2u*)(xb + (size_t)m * DM) + lane; float s = 0.f;
#pragma unroll
        for (int j = 0; j < 8; ++j) { const f32x4 v = xr[64 * j]; s += (v[0] * v[0] + v[1] * v[1]) + (v[2] * v[2] + v[3] * v[3]); v2u w; w.x = pk2(v[0], v[1]); w.y = pk2(v[2], v[3]); o[64 * j] = w; }
        s = wave_sum(s); if (lane == 0) ss[m] = s;
    }
    const int gt = fresh_bid() * 512 + fresh_tid(), NT = gridDim.x * 512;
    for (int i = gt; i < 3 * T; i += NT) ss[T + i] = 0.f;
}

__device__ __forceinline__ void knorm_unit(const Params& P, int layer, int ku, LAS unsigned char* lds) {
    const int tid = fresh_tid(); const int b = ku >> 7, blk = (ku >> 3) & 15, h = ku & 7;
    bf16* PT = (bf16*)(P.ws + OFF_PT); float* kmean = (float*)(P.ws + OFF_KMEAN); const float* kw = P.in[4] + layer * 128;
    const int row = tid >> 1, half = tid & 1; const int t = b * SEQ + blk * 256 + row;
    bf16* kp = PT + (size_t)t * NPT + PT_K + h * 128 + half * 64;
    v4u raw[8]; float ss = 0.f;
#pragma unroll
    for (int j = 0; j < 8; ++j) { raw[j] = *(const v4u*)(kp + 8 * j);
#pragma unroll
        for (int e = 0; e < 4; ++e) { const float a = bflo(raw[j][e]), c = bfhi(raw[j][e]); ss += a * a + c * c; } }
    ss += __shfl_xor(ss, 1);
    const float rs = __builtin_amdgcn_rsqf(ss * (1.f / 128.f) + EPS);
    LAS bf16* lk = (LAS bf16*)lds;
#pragma unroll
    for (int j = 0; j < 8; ++j) { const f32x4 w0 = *(const f32x4*)(kw + half * 64 + 8 * j), w1 = *(const f32x4*)(kw + half * 64 + 8 * j + 4); v4u o;
        o.x = pk2(bflo(raw[j].x) * rs * w0[0], bfhi(raw[j].x) * rs * w0[1]); o.y = pk2(bflo(raw[j].y) * rs * w0[2], bfhi(raw[j].y) * rs * w0[3]);
        o.z = pk2(bflo(raw[j].z) * rs * w1[0], bfhi(raw[j].z) * rs * w1[1]); o.w = pk2(bflo(raw[j].w) * rs * w1[2], bfhi(raw[j].w) * rs * w1[3]);
        *(v4u*)(kp + 8 * j) = o; *(LAS v4u*)(lk + row * 128 + half * 64 + 8 * j) = o; }
    __syncthreads();
    LAS float* lp = (LAS float*)(lds + 65536);
    { const int c = tid & 127, part = tid >> 7; float s = 0.f;
#pragma unroll 8
      for (int i = 0; i < 64; ++i) s += bf1(lk[(part * 64 + i) * 128 + c]);
      lp[part * 128 + c] = s; }
    __syncthreads();
    if (tid < 128) kmean[((size_t)(b * 8 + h) * 16 + blk) * 128 + tid] = (lp[tid] + lp[128 + tid] + lp[256 + tid] + lp[384 + tid]) * (1.f / 256.f);
    __syncthreads();
}

__device__ __forceinline__ void ssd_prep_unit(const Params& P, int layer, int su, LAS unsigned char* lds) {
    const int tid = fresh_tid(), lane = tid & 63, wave = tid >> 6; const int b = su >> 6, c = (su >> 1) & 31, g = su & 1;
    const int t0 = b * SEQ + c * 128, s0 = c * 128;
    unsigned char* ws = P.ws; const bf16* PT = (const bf16*)(ws + OFF_PT); const bf16* CT = (const bf16*)(ws + OFF_CT); bf16* CC = (bf16*)(ws + OFF_CC); bf16* BMCM = (bf16*)(ws + OFF_BMCM);
    float* DTt = (float*)(ws + OFF_DT); float* ACt = (float*)(ws + OFF_ACUM); float* CDEC = (float*)(ws + OFF_CDEC); float* STATES = (float*)(ws + OFF_STATES);
    const float* cw = P.in[5] + (size_t)layer * 4 * 1536; const float* cb = P.in[6] + layer * 1536;
    LAS float* wts = (LAS float*)lds;
    { const int hd = 8 * g + wave; const int l = 2 * lane;
      const float bias = P.in[7][layer * 16 + hd]; const float a = -__expf(P.in[8][layer * 16 + hd]);
      float v0 = bf1(PT[(size_t)(t0 + l) * NPT + PT_DT + hd]) + bias, v1 = bf1(PT[(size_t)(t0 + l + 1) * NPT + PT_DT + hd]) + bias;
      const float d0 = v0 > 20.f ? v0 : log1pf(__expf(v0)), d1 = v1 > 20.f ? v1 : log1pf(__expf(v1));
      const float la0 = d0 * a, la1 = d1 * a; float x = la0 + la1;
#pragma unroll
      for (int o = 1; o < 64; o <<= 1) { const float y = __shfl_up(x, o); if (lane >= o) x += y; }
      const float ac1 = x, ac0 = x - la1; const float tot = __shfl(x, 63);
      const size_t o2 = (size_t)(b * 16 + hd) * SEQ + s0 + l;
      *(f32x2*)(DTt + o2) = (f32x2){d0, d1}; *(f32x2*)(ACt + o2) = (f32x2){ac0, ac1};
      wts[wave * 128 + l] = d0 * __expf(tot - ac0); wts[wave * 128 + l + 1] = d1 * __expf(tot - ac1);
      if (lane == 63) CDEC[(b * 32 + c) * 16 + hd] = __expf(tot); }
    for (int it = tid; it < 640 * 16; it += 512) {
        const int row = it >> 4, sg = it & 15; int ctrow, ch, ccrow;
        if (row < 512) { ctrow = 1024 + 512 * g + row; ch = 512 * g + row; ccrow = 512 * g + row; } else { ctrow = 2048 + 128 * g + (row - 512); ch = 1024 + 128 * g + (row - 512); ccrow = 1024 + 128 * g + (row - 512); }
        const bf16* src = CT + (size_t)ctrow * T + t0 + 8 * sg;
        const v4u cur = *(const v4u*)src; v4u prev = (v4u){0u, 0u, 0u, 0u}; if (s0 + 8 * sg > 0) prev = *(const v4u*)(src - 8);
        const float w0 = cw[ch], w1 = cw[1536 + ch], w2 = cw[2 * 1536 + ch], w3 = cw[3 * 1536 + ch], bi = cb[ch];
        float xv[11]; xv[0] = bfhi(prev.z); xv[1] = bflo(prev.w); xv[2] = bfhi(prev.w);
        xv[3] = bflo(cur.x); xv[4] = bfhi(cur.x); xv[5] = bflo(cur.y); xv[6] = bfhi(cur.y); xv[7] = bflo(cur.z); xv[8] = bfhi(cur.z); xv[9] = bflo(cur.w); xv[10] = bfhi(cur.w);
        float o[8];
#pragma unroll
        for (int i = 0; i < 8; ++i) o[i] = silu_f(bi + w0 * xv[i] + w1 * xv[i + 1] + w2 * xv[i + 2] + w3 * xv[i + 3]);
        v4u ov; ov.x = pk2(o[0], o[1]); ov.y = pk2(o[2], o[3]); ov.z = pk2(o[4], o[5]); ov.w = pk2(o[6], o[7]);
        *(v4u*)(CC + (size_t)ccrow * T + t0 + 8 * sg) = ov;
    }
    { const int cgp = tid & 31, run = tid >> 5; int ptcol, ch0, ocol;
      if (cgp < 16) { ptcol = PT_BM + 128 * g + 8 * cgp; ch0 = 1024 + 128 * g + 8 * cgp; ocol = 128 * g + 8 * cgp; } else { ptcol = PT_CM + 128 * g + 8 * (cgp - 16); ch0 = 1280 + 128 * g + 8 * (cgp - 16); ocol = 256 + 128 * g + 8 * (cgp - 16); }
      float w[4][8], bi[8];
#pragma unroll
      for (int k = 0; k < 4; ++k) { const f32x4 a = *(const f32x4*)(cw + k * 1536 + ch0), bq = *(const f32x4*)(cw + k * 1536 + ch0 + 4);
#pragma unroll
          for (int e = 0; e < 4; ++e) { w[k][e] = a[e]; w[k][4 + e] = bq[e]; } }
      { const f32x4 a = *(const f32x4*)(cb + ch0), bq = *(const f32x4*)(cb + ch0 + 4);
#pragma unroll
        for (int e = 0; e < 4; ++e) { bi[e] = a[e]; bi[4 + e] = bq[e]; } }
      float x1[8], x2[8], x3[8];
      const int sb = s0 + 8 * run;
#define HALO_ROW(k, d) do { v4u r_ = (v4u){0u, 0u, 0u, 0u}; if (sb - (k) >= 0) r_ = *(const v4u*)(PT + (size_t)(t0 + 8 * run - (k)) * NPT + ptcol); \
          _Pragma("unroll") for (int e = 0; e < 4; ++e) { d[2 * e] = bflo(r_[e]); d[2 * e + 1] = bfhi(r_[e]); } } while (0)
      HALO_ROW(1, x1); HALO_ROW(2, x2); HALO_ROW(3, x3);
#undef HALO_ROW
#pragma unroll
      for (int i = 0; i < 8; ++i) { const v4u r = *(const v4u*)(PT + (size_t)(t0 + 8 * run + i) * NPT + ptcol); float x0[8], o[8];
#pragma unroll
          for (int e = 0; e < 4; ++e) { x0[2 * e] = bflo(r[e]); x0[2 * e + 1] = bfhi(r[e]); }
#pragma unroll
          for (int e = 0; e < 8; ++e) { o[e] = silu_f(bi[e] + w[0][e] * x3[e] + w[1][e] * x2[e] + w[2][e] * x1[e] + w[3][e] * x0[e]); x3[e] = x2[e]; x2[e] = x1[e]; x1[e] = x0[e]; }
          v4u ov; ov.x = pk2(o[0], o[1]); ov.y = pk2(o[2], o[3]); ov.z = pk2(o[4], o[5]); ov.w = pk2(o[6], o[7]);
          *(v4u*)(BMCM + (size_t)(t0 + 8 * run + i) * 512 + ocol) = ov; } }
    __syncthreads();
    { const int hd = 8 * g + wave, i16 = lane & 15, quad = lane >> 4;
      bf16x8 Af[4][4];
#pragma unroll
      for (int pt = 0; pt < 4; ++pt)
#pragma unroll
          for (int ls = 0; ls < 4; ++ls) { const v4u r = *(const v4u*)(CC + (size_t)(512 * g + 64 * wave + 16 * pt + i16) * T + t0 + 32 * ls + 8 * quad);
              const LAS float* wp = wts + wave * 128 + 32 * ls + 8 * quad; v4u o;
              o.x = pk2(bflo(r.x) * wp[0], bfhi(r.x) * wp[1]); o.y = pk2(bflo(r.y) * wp[2], bfhi(r.y) * wp[3]); o.z = pk2(bflo(r.z) * wp[4], bfhi(r.z) * wp[5]); o.w = pk2(bflo(r.w) * wp[6], bfhi(r.w) * wp[7]);
              Af[pt][ls] = __builtin_bit_cast(bf16x8, o); }
      float* st = STATES + (size_t)((b * 32 + c) * 16 + hd) * 8192;
#pragma unroll 1
      for (int nt = 0; nt < 8; ++nt) { bf16x8 Bf[4];
#pragma unroll
          for (int ls = 0; ls < 4; ++ls) Bf[ls] = *(const bf16x8*)(CC + (size_t)(1024 + 128 * g + 16 * nt + i16) * T + t0 + 32 * ls + 8 * quad);
#pragma unroll
          for (int pt = 0; pt < 4; ++pt) { f32x4 acc = (f32x4){0.f, 0.f, 0.f, 0.f};
#pragma unroll
              for (int ls = 0; ls < 4; ++ls) acc = MFMA16(Af[pt][ls], Bf[ls], acc);
#pragma unroll
              for (int r = 0; r < 4; ++r) st[(16 * pt + 4 * quad + r) * 128 + 16 * nt + i16] = acc[r]; } } }
    __syncthreads();
}

__device__ __forceinline__ void scan_phase(const Params& P) {
    const float* STATES = (const float*)(P.ws + OFF_STATES); const float* CDEC = (const float*)(P.ws + OFF_CDEC); bf16* HIN = (bf16*)(P.ws + OFF_HIN);
    const int gt = fresh_bid() * 512 + fresh_tid(), NT = gridDim.x * 512;
    for (int item = gt; item < 64 * 2048; item += NT) { const int bh = item >> 11, e4 = (item & 2047) * 4; const int b = bh >> 4, hd = bh & 15;
        f32x4 h = (f32x4){0.f, 0.f, 0.f, 0.f};
#pragma unroll 4
        for (int c = 0; c < 32; ++c) { const size_t base = (size_t)((b * 32 + c) * 16 + hd) * 8192 + e4;
            v2u o; o.x = pk2(h[0], h[1]); o.y = pk2(h[2], h[3]); *(v2u*)(HIN + base) = o;
            const float dec = CDEC[(b * 32 + c) * 16 + hd]; const f32x4 st = *(const f32x4*)(STATES + base); h = h * dec + st; } }
}

__device__ __forceinline__ void attn_unit(const Params& P, int layer, int b, int h, int i, LAS unsigned char* lds) {
    const int tid = fresh_tid(), lane = tid & 63, w = tid >> 6, i16 = lane & 15, quad = lane >> 4;
    unsigned char* ws = P.ws; const bf16* PT = (const bf16*)(ws + OFF_PT); const bf16* CT = (const bf16*)(ws + OFF_CT); bf16* MIX = (bf16*)(ws + OFF_MIX); const float* kmean = (const float*)(ws + OFF_KMEAN);
    const float* qw = P.in[3] + layer * 128; const float* kw = P.in[4] + layer * 128;
    const float mq = wave_max(fmaxf(fabsf(qw[lane]), fabsf(qw[lane + 64]))), mk = wave_max(fmaxf(fabsf(kw[lane]), fabsf(kw[lane + 64])));
    const float C2 = 0.08838834764831845f * 1.4426950408889634f; const float Bnd = C2 * 128.f * mq * mk;
    float qf[2][32]; unsigned selmask[2];
#pragma unroll
    for (int qt = 0; qt < 2; ++qt) { const int t = b * SEQ + 256 * i + 32 * w + 16 * qt + i16; const bf16* qp = PT + (size_t)t * NPT + PT_Q + h * 128 + 8 * quad; float ss = 0.f;
#pragma unroll
        for (int s = 0; s < 4; ++s) { const v4u r = *(const v4u*)(qp + 32 * s);
#pragma unroll
            for (int e = 0; e < 4; ++e) { const float a = bflo(r[e]), c = bfhi(r[e]); qf[qt][8 * s + 2 * e] = a; qf[qt][8 * s + 2 * e + 1] = c; ss += a * a + c * c; } }
        ss += __shfl_xor(ss, 16); ss += __shfl_xor(ss, 32);
        const float rs = __builtin_amdgcn_rsqf(ss * (1.f / 128.f) + EPS);
#pragma unroll
        for (int s = 0; s < 4; ++s) { const f32x4 w0 = *(const f32x4*)(qw + 32 * s + 8 * quad), w1 = *(const f32x4*)(qw + 32 * s + 8 * quad + 4);
#pragma unroll
            for (int e = 0; e < 4; ++e) { qf[qt][8 * s + e] *= rs * w0[e]; qf[qt][8 * s + 4 + e] *= rs * w1[e]; } } }
    { float g0[16], g1[16];
#pragma unroll
      for (int j = 0; j < 16; ++j) { g0[j] = 0.f; g1[j] = 0.f;
          if (j < i) { const float* km = kmean + ((size_t)(b * 8 + h) * 16 + j) * 128 + 8 * quad; float p0 = 0.f, p1 = 0.f;
#pragma unroll
              for (int s = 0; s < 4; ++s) { const f32x4 k0 = *(const f32x4*)(km + 32 * s), k1 = *(const f32x4*)(km + 32 * s + 4);
#pragma unroll
                  for (int e = 0; e < 4; ++e) { p0 += qf[0][8 * s + e] * k0[e] + qf[0][8 * s + 4 + e] * k1[e]; p1 += qf[1][8 * s + e] * k0[e] + qf[1][8 * s + 4 + e] * k1[e]; } }
              p0 += __shfl_xor(p0, 16); p0 += __shfl_xor(p0, 32); p1 += __shfl_xor(p1, 16); p1 += __shfl_xor(p1, 32); g0[j] = p0; g1[j] = p1; } }
      unsigned m0 = 0u, m1 = 0u;
#pragma unroll
      for (int r = 0; r < 3; ++r) { float b0 = -INFINITY, b1 = -INFINITY; int i0 = -1, i1 = -1;
#pragma unroll
          for (int j = 0; j < 16; ++j) { if (j < i) { if (!((m0 >> j) & 1u) && g0[j] > b0) { b0 = g0[j]; i0 = j; } if (!((m1 >> j) & 1u) && g1[j] > b1) { b1 = g1[j]; i1 = j; } } }
          if (i0 >= 0) m0 |= 1u << i0; if (i1 >= 0) m1 |= 1u << i1; }
      selmask[0] = m0; selmask[1] = m1; }
    bf16x8 Qf[2][4];
#pragma unroll
    for (int qt = 0; qt < 2; ++qt)
#pragma unroll
        for (int s = 0; s < 4; ++s) { v4u o;
            o.x = pk2(qf[qt][8 * s + 0] * C2, qf[qt][8 * s + 1] * C2); o.y = pk2(qf[qt][8 * s + 2] * C2, qf[qt][8 * s + 3] * C2);
            o.z = pk2(qf[qt][8 * s + 4] * C2, qf[qt][8 * s + 5] * C2); o.w = pk2(qf[qt][8 * s + 6] * C2, qf[qt][8 * s + 7] * C2);
            Qf[qt][s] = __builtin_bit_cast(bf16x8, o); }
    unsigned wsel = selmask[0] | selmask[1];
#pragma unroll
    for (int o = 1; o < 64; o <<= 1) wsel |= (unsigned)__shfl_xor((int)wsel, o);
    f32x4 O[2][8]; float lsum[2] = {0.f, 0.f};
#pragma unroll
    for (int qt = 0; qt < 2; ++qt)
#pragma unroll
        for (int dt = 0; dt < 8; ++dt) O[qt][dt] = (f32x4){0.f, 0.f, 0.f, 0.f};
    const int ntiles = (i + 1) * 4;
    v4u kr[2], vr[2];
#define ATT_LOAD(n) do { const int _j = (n) >> 2, _kt = (n) & 3; const int _tk = b * SEQ + 256 * _j + 64 * _kt; \
        _Pragma("unroll") for (int _c = 0; _c < 2; ++_c) { const int cid = tid + 512 * _c; \
            kr[_c] = *(const v4u*)(PT + (size_t)(_tk + (cid >> 4)) * NPT + PT_K + h * 128 + 8 * (cid & 15)); \
            vr[_c] = *(const v4u*)(CT + (size_t)(h * 128 + (cid >> 3)) * T + _tk + 8 * (cid & 7)); } } while (0)
#define ATT_STORE(buf) do { LAS unsigned char* _kb = lds + (buf) * 32768; LAS unsigned char* _vb = _kb + 16384; \
        _Pragma("unroll") for (int _c = 0; _c < 2; ++_c) { const int cid = tid + 512 * _c; const int kr_ = cid >> 4, kc_ = cid & 15, vd_ = cid >> 3, vc_ = cid & 7; \
            *(LAS v4u*)(_kb + kr_ * 256 + 16 * (kc_ ^ ((kr_ & 3) | (((kr_ >> 3) & 3) << 2)))) = kr[_c]; \
            *(LAS v4u*)(_vb + vd_ * 128 + 16 * (vc_ ^ ((vd_ >> 1) & 7))) = vr[_c]; } } while (0)
    ATT_LOAD(0); ATT_STORE(0); __syncthreads();
#pragma unroll 1
    for (int n = 0; n < ntiles; ++n) {
        const int cur = n & 1; const int j = n >> 2, kt = n & 3; const bool own = (j == i);
        if (n + 1 < ntiles) ATT_LOAD(n + 1);
        const bool active = own ? (64 * kt <= 32 * w + 31) : (((wsel >> j) & 1u) != 0u);
        if (active) {
            const LAS unsigned char* kb = lds + cur * 32768; const LAS unsigned char* vb = kb + 16384;
#pragma unroll
            for (int kk = 0; kk < 2; ++kk) {
                const int rka = 32 * kk + 8 * (i16 >> 2) + (i16 & 3);
                bf16x8 Pf[2];
                { bf16x8 Ka[4], Kb[4];
#pragma unroll
                  for (int s = 0; s < 4; ++s) { Ka[s] = *(const LAS bf16x8*)(kb + rka * 256 + 16 * ((4 * s + quad) ^ i16)); Kb[s] = *(const LAS bf16x8*)(kb + (rka + 4) * 256 + 16 * ((4 * s + quad) ^ i16)); }
#pragma unroll
                  for (int qt = 0; qt < 2; ++qt) {
                    f32x4 Sa = (f32x4){0.f, 0.f, 0.f, 0.f}, Sb = (f32x4){0.f, 0.f, 0.f, 0.f};
#pragma unroll
                    for (int s = 0; s < 4; ++s) { Sa = MFMA16(Ka[s], Qf[qt][s], Sa); Sb = MFMA16(Kb[s], Qf[qt][s], Sb); }
                    float pa[4], pb[4]; const int qpos = 32 * w + 16 * qt + i16; const int kbase = 64 * kt + 32 * kk + 8 * quad; const bool selj = ((selmask[qt] >> j) & 1u) != 0u;
#pragma unroll
                    for (int r = 0; r < 4; ++r) { const bool va = own ? (kbase + r <= qpos) : selj, vb2 = own ? (kbase + 4 + r <= qpos) : selj;
                        pa[r] = va ? __builtin_amdgcn_exp2f(Sa[r] - Bnd) : 0.f; pb[r] = vb2 ? __builtin_amdgcn_exp2f(Sb[r] - Bnd) : 0.f; }
                    lsum[qt] += (pa[0] + pa[1]) + (pa[2] + pa[3]) + (pb[0] + pb[1]) + (pb[2] + pb[3]);
                    v4u pk; pk.x = pk2(pa[0], pa[1]); pk.y = pk2(pa[2], pa[3]); pk.z = pk2(pb[0], pb[1]); pk.w = pk2(pb[2], pb[3]);
                    Pf[qt] = __builtin_bit_cast(bf16x8, pk);
                  } }
#pragma unroll
                for (int dh = 0; dh < 2; ++dh) { bf16x8 Vf[4];
#pragma unroll
                    for (int d4 = 0; d4 < 4; ++d4) { const int d = 16 * (4 * dh + d4) + i16; Vf[d4] = *(const LAS bf16x8*)(vb + d * 128 + 16 * ((4 * kk + quad) ^ ((d >> 1) & 7))); }
#pragma unroll
                    for (int qt = 0; qt < 2; ++qt)
#pragma unroll
                        for (int d4 = 0; d4 < 4; ++d4) O[qt][4 * dh + d4] = MFMA16(Vf[d4], Pf[qt], O[qt][4 * dh + d4]);
                    asm volatile("" ::: "memory"); }
            }
        }
        if (n + 1 < ntiles) ATT_STORE(cur ^ 1);
        __syncthreads();
    }
#undef ATT_LOAD
#undef ATT_STORE
#pragma unroll
    for (int qt = 0; qt < 2; ++qt) { float l = lsum[qt]; l += __shfl_xor(l, 16); l += __shfl_xor(l, 32); const float inv = 1.f / l;
        const int t = b * SEQ + 256 * i + 32 * w + 16 * qt + i16; bf16* op = MIX + (size_t)t * DM + h * 128 + 4 * quad;
#pragma unroll
        for (int dt = 0; dt < 8; ++dt) { v2u o; o.x = pk2(O[qt][dt][0] * inv, O[qt][dt][1] * inv); o.y = pk2(O[qt][dt][2] * inv, O[qt][dt][3] * inv); *(v2u*)(op + 16 * dt) = o; } }
}

__device__ __forceinline__ void ssd_out_unit(const Params& P, int layer, int su) {
    const int tid = fresh_tid(), lane = tid & 63, w = tid >> 6, i16 = lane & 15, quad = lane >> 4; const int b = su >> 6, c = (su >> 1) & 31, g = su & 1;
    const int t0 = b * SEQ + c * 128, s0 = c * 128; const int lq = 16 * w + i16; const int t = t0 + lq;
    unsigned char* ws = P.ws; const bf16* PT = (const bf16*)(ws + OFF_PT); const bf16* CC = (const bf16*)(ws + OFF_CC); const bf16* BMCM = (const bf16*)(ws + OFF_BMCM); bf16* MIX = (bf16*)(ws + OFF_MIX);
    const float* DTt = (const float*)(ws + OFF_DT); const float* ACt = (const float*)(ws + OFF_ACUM); const bf16* HIN = (const bf16*)(ws + OFF_HIN);
    const float* dskip = P.in[9] + layer * 16; const float* nw = P.in[10] + layer * 1024;
    bf16x8 Bcm[4];
#pragma unroll
    for (int ns = 0; ns < 4; ++ns) Bcm[ns] = *(const bf16x8*)(BMCM + (size_t)t * 512 + 256 + 128 * g + 32 * ns + 8 * quad);
    const int nss = (w >> 1) + 1;
    f32x4 CBa[4], CBb[4];
#pragma unroll
    for (int ss = 0; ss < 4; ++ss) { CBa[ss] = (f32x4){0.f, 0.f, 0.f, 0.f}; CBb[ss] = (f32x4){0.f, 0.f, 0.f, 0.f};
        if (ss < nss) { const int sa = 32 * ss + 8 * (i16 >> 2) + (i16 & 3);
#pragma unroll
            for (int ns = 0; ns < 4; ++ns) { const bf16x8 Aa = *(const bf16x8*)(BMCM + (size_t)(t0 + sa) * 512 + 128 * g + 32 * ns + 8 * quad), Ab = *(const bf16x8*)(BMCM + (size_t)(t0 + sa + 4) * 512 + 128 * g + 32 * ns + 8 * quad);
                CBa[ss] = MFMA16(Aa, Bcm[ns], CBa[ss]); CBb[ss] = MFMA16(Ab, Bcm[ns], CBb[ss]); } } }
    float ssq = 0.f;
#pragma unroll 1
    for (int r = 0; r < 8; ++r) { const int hd = 8 * g + r; const size_t hoff = (size_t)(b * 16 + hd) * SEQ + s0;
        const float al = ACt[hoff + lq]; const float el = __expf(al);
        f32x4 yd[4], yo[4];
#pragma unroll
        for (int pt = 0; pt < 4; ++pt) { yd[pt] = (f32x4){0.f, 0.f, 0.f, 0.f}; yo[pt] = (f32x4){0.f, 0.f, 0.f, 0.f}; }
#pragma unroll
        for (int ss = 0; ss < 4; ++ss) { if (ss < nss) { const int sb = 32 * ss + 8 * quad;
                const f32x4 a0 = *(const f32x4*)(ACt + hoff + sb), a1 = *(const f32x4*)(ACt + hoff + sb + 4), d0 = *(const f32x4*)(DTt + hoff + sb), d1 = *(const f32x4*)(DTt + hoff + sb + 4);
                float m[8];
#pragma unroll
                for (int e = 0; e < 4; ++e) { m[e] = (sb + e <= lq) ? CBa[ss][e] * __expf(al - a0[e]) * d0[e] : 0.f; m[4 + e] = (sb + 4 + e <= lq) ? CBb[ss][e] * __expf(al - a1[e]) * d1[e] : 0.f; }
                v4u pk; pk.x = pk2(m[0], m[1]); pk.y = pk2(m[2], m[3]); pk.z = pk2(m[4], m[5]); pk.w = pk2(m[6], m[7]); const bf16x8 Bm = __builtin_bit_cast(bf16x8, pk);
#pragma unroll
                for (int pt = 0; pt < 4; ++pt) { const bf16x8 Ax = *(const bf16x8*)(CC + (size_t)(512 * g + 64 * r + 16 * pt + i16) * T + t0 + sb); yd[pt] = MFMA16(Ax, Bm, yd[pt]); } } }
        const bf16* hp = HIN + (size_t)((b * 32 + c) * 16 + hd) * 8192;
#pragma unroll
        for (int pt = 0; pt < 4; ++pt)
#pragma unroll
            for (int ns = 0; ns < 4; ++ns) { const bf16x8 Ah = *(const bf16x8*)(hp + (16 * pt + i16) * 128 + 32 * ns + 8 * quad); yo[pt] = MFMA16(Ah, Bcm[ns], yo[pt]); }
        const float dsk = dskip[hd];
#pragma unroll
        for (int pt = 0; pt < 4; ++pt) { const int p0 = 16 * pt + 4 * quad; const int chn = 512 * g + 64 * r + p0;
            const v2u zr = *(const v2u*)(PT + (size_t)t * NPT + PT_Z + chn); const float z[4] = {bflo(zr.x), bfhi(zr.x), bflo(zr.y), bfhi(zr.y)}; float v[4];
#pragma unroll
            for (int e = 0; e < 4; ++e) { const float xs = bf1(CC[(size_t)(chn + e) * T + t]); const float y = yd[pt][e] + yo[pt][e] * el + dsk * xs; v[e] = y * silu_f(z[e]); ssq += v[e] * v[e]; }
            v2u o; o.x = pk2(v[0], v[1]); o.y = pk2(v[2], v[3]); *(v2u*)(MIX + (size_t)t * DM + 1024 + chn) = o; } }
    ssq += __shfl_xor(ssq, 16); ssq += __shfl_xor(ssq, 32);
    const float rs = __builtin_amdgcn_rsqf(ssq * (1.f / 512.f) + EPS);
#pragma unroll 1
    for (int r = 0; r < 8; ++r)
#pragma unroll
        for (int pt = 0; pt < 4; ++pt) { const int chn = 512 * g + 64 * r + 16 * pt + 4 * quad; bf16* mp = MIX + (size_t)t * DM + 1024 + chn;
            const v2u vr = *(const v2u*)mp; const f32x4 wv = *(const f32x4*)(nw + chn);
            v2u o; o.x = pk2(bflo(vr.x) * rs * wv[0], bfhi(vr.x) * rs * wv[1]); o.y = pk2(bflo(vr.y) * rs * wv[2], bfhi(vr.y) * rs * wv[3]); *(v2u*)mp = o; }
}

__device__ __forceinline__ void ffn_conv_phase(const Params& P, int layer) {
    const bf16* U = (const bf16*)(P.ws + OFF_U); bf16* G = (bf16*)(P.ws + OFF_G);
    const float* cw = P.in[14] + (size_t)layer * 3 * NUP; const float* cb = P.in[15] + (size_t)layer * NUP;
    const int gt = fresh_bid() * 512 + fresh_tid(), NT = gridDim.x * 512;
    constexpr int NFG = DFF / 8, RUN = 32, NITEM = (T / RUN) * NFG;
    for (int item = gt; item < NITEM; item += NT) { const int tr = item / NFG, fg = item - tr * NFG; const int f0 = 8 * fg; const int tb = tr * RUN; const int sb = tb & (SEQ - 1);
        float wg[3][8], wv[3][8], bg[8], bv[8];
#pragma unroll
        for (int k = 0; k < 3; ++k) { const f32x4 a = *(const f32x4*)(cw + (size_t)k * NUP + f0), a2 = *(const f32x4*)(cw + (size_t)k * NUP + f0 + 4), c = *(const f32x4*)(cw + (size_t)k * NUP + DFF + f0), c2 = *(const f32x4*)(cw + (size_t)k * NUP + DFF + f0 + 4);
#pragma unroll
            for (int e = 0; e < 4; ++e) { wg[k][e] = a[e]; wg[k][4 + e] = a2[e]; wv[k][e] = c[e]; wv[k][4 + e] = c2[e]; } }
        { const f32x4 a = *(const f32x4*)(cb + f0), a2 = *(const f32x4*)(cb + f0 + 4), c = *(const f32x4*)(cb + DFF + f0), c2 = *(const f32x4*)(cb + DFF + f0 + 4);
#pragma unroll
          for (int e = 0; e < 4; ++e) { bg[e] = a[e]; bg[4 + e] = a2[e]; bv[e] = c[e]; bv[4 + e] = c2[e]; } }
        float g1[8], g2[8], v1[8], v2[8];
#define HALO_ROW(k, dg, dv) do { v4u rg_ = (v4u){0u, 0u, 0u, 0u}, rv_ = (v4u){0u, 0u, 0u, 0u}; \
            if (sb - (k) >= 0) { rg_ = *(const v4u*)(U + (size_t)(tb - (k)) * NUP + f0); rv_ = *(const v4u*)(U + (size_t)(tb - (k)) * NUP + DFF + f0); } \
            _Pragma("unroll") for (int e = 0; e < 4; ++e) { dg[2 * e] = bflo(rg_[e]); dg[2 * e + 1] = bfhi(rg_[e]); dv[2 * e] = bflo(rv_[e]); dv[2 * e + 1] = bfhi(rv_[e]); } } while (0)
        HALO_ROW(1, g1, v1); HALO_ROW(2, g2, v2);
#undef HALO_ROW
#pragma unroll 4
        for (int i = 0; i < RUN; ++i) { const v4u rg = *(const v4u*)(U + (size_t)(tb + i) * NUP + f0), rv = *(const v4u*)(U + (size_t)(tb + i) * NUP + DFF + f0); float g0[8], v0[8], o[8];
#pragma unroll
            for (int e = 0; e < 4; ++e) { g0[2 * e] = bflo(rg[e]); g0[2 * e + 1] = bfhi(rg[e]); v0[2 * e] = bflo(rv[e]); v0[2 * e + 1] = bfhi(rv[e]); }
#pragma unroll
            for (int e = 0; e < 8; ++e) { const float ug = bg[e] + wg[0][e] * g2[e] + wg[1][e] * g1[e] + wg[2][e] * g0[e]; const float uv = bv[e] + wv[0][e] * v2[e] + wv[1][e] * v1[e] + wv[2][e] * v0[e];
                o[e] = silu_f(ug) * uv; g2[e] = g1[e]; g1[e] = g0[e]; v2[e] = v1[e]; v1[e] = v0[e]; }
            v4u ov; ov.x = pk2(o[0], o[1]); ov.y = pk2(o[2], o[3]); ov.z = pk2(o[4], o[5]); ov.w = pk2(o[6], o[7]);
            *(v4u*)(G + (size_t)(tb + i) * DFF + f0) = ov; } }
}

__global__ void __launch_bounds__(512, 2) hymba_fwd(Params P) {
    extern __shared__ __attribute__((aligned(16))) unsigned char lds[];
    cg::grid_group grid = cg::this_grid();
    const int G = gridDim.x, bx = blockIdx.x;
    unsigned char* ws = P.ws;
    LAS unsigned char* llds = (LAS unsigned char*)lds;
    PG8_LAS unsigned char* glds = (PG8_LAS unsigned char*)lds;
    bf16* XB = (bf16*)(ws + OFF_XB); float* SS = (float*)(ws + OFF_SS);

    phase_x0(P);
    convert_jobs(P, 0, 0, 8, llds);
    grid.sync();
#pragma unroll 1
    for (int L = 0; L < 2; ++L) {
        { pg8::Gemm g{XB, (const bf16*)(ws + OFF_WB), (const bf16*)(ws + OFF_WA), XB, DM};
          pg8::DualOrder S{T / 256, NPT / 256, NCT / 256, T / 256, G, bx};
          pg8::EpiScale E{(bf16*)(ws + OFF_PT), NPT, (bf16*)(ws + OFF_CT), T, SS + (2 * L) * T, 1.f / DM};
          pg8::gemm_phase<pg8::EpiScale, pg8::DualOrder, true, true>(glds, g, S, E); }
        grid.sync();
#ifndef NO_PREP
        for (int u = bx; u < 256; u += G) ssd_prep_unit(P, L, u, llds);
#endif
#ifndef NO_KNORM
        for (int u = bx; u < 512; u += G) knorm_unit(P, L, u, llds);
#endif
        if (L == 1) convert_jobs(P, 1, 7, 8, llds);
        grid.sync();
        scan_phase(P);
#ifndef NO_ATTN
        for (int u = bx; u < 256; u += G) { const int bh = u >> 3, pi = u & 7;
#pragma unroll 1
            for (int rep = 0; rep < 2; ++rep) attn_unit(P, L, bh >> 3, bh & 7, rep ? pi : 15 - pi, llds); }
#endif
        grid.sync();
#ifndef NO_SSDOUT
        for (int u = bx; u < 256; u += G) ssd_out_unit(P, L, u);
#endif
        grid.sync();
        { pg8::Gemm g{(const bf16*)(ws + OFF_MIX), nullptr, (const bf16*)(ws + OFF_WOUT), nullptr, DM};
          pg8::DualOrder S{T / 256, DM / 256, 0, 0, G, bx};
          pg8::EpiResid E{L == 0 ? P.in[0] : P.out, P.out, XB, SS + (2 * L + 1) * T};
          pg8::gemm_phase<pg8::EpiResid, pg8::DualOrder, true, true>(glds, g, S, E); }
        grid.sync();
        { pg8::Gemm g{XB, nullptr, (const bf16*)(ws + OFF_WUP), nullptr, DM};
          pg8::DualOrder S{T / 256, NUP / 256, 0, 0, G, bx};
          pg8::EpiScale E{(bf16*)(ws + OFF_U), NUP, nullptr, 0, SS + (2 * L + 1) * T, 1.f / DM};
          pg8::gemm_phase<pg8::EpiScale, pg8::DualOrder, true, true>(glds, g, S, E); }
        grid.sync();
#ifndef NO_FFNCONV
        ffn_conv_phase(P, L);
#endif
        if (L == 0) convert_jobs(P, 1, 0, 7, llds);
        grid.sync();
        { pg8::Gemm g{(const bf16*)(ws + OFF_G), nullptr, (const bf16*)(ws + OFF_WDOWN), nullptr, DFF};
          pg8::DualOrder S{T / 256, DM / 256, 0, 0, G, bx};
          pg8::EpiResid E{P.out, P.out, XB, L == 0 ? SS + 2 * T : nullptr};
          pg8::gemm_phase<pg8::EpiResid, pg8::DualOrder, true, true>(glds, g, S, E); }
        if (L == 0) grid.sync();
    }
}

extern "C" void kernel_launch(void* const* d_in, const int* in_sizes, int n_in, void* d_out, int out_size, void* d_ws, size_t ws_size, hipStream_t stream) {
    static int grid = 0;
    if (grid == 0) {
        if (n_in != 17 || in_sizes[0] != T * DM || out_size != T * DM || ws_size < WS_NEED) { fprintf(stderr, "kernel_launch: unexpected shapes / workspace (n_in %d, ws %zu, need %zu)\n", n_in, ws_size, (size_t)WS_NEED); grid = -1; return; }
        int dev = 0, cus = 0, per_cu = 0;
        hipGetDevice(&dev); hipDeviceGetAttribute(&cus, hipDeviceAttributeMultiprocessorCount, dev);
        if (hipFuncSetAttribute((const void*)hymba_fwd, hipFuncAttributeMaxDynamicSharedMemorySize, LDS_BYTES) != hipSuccess) { fprintf(stderr, "kernel_launch: hipFuncSetAttribute failed\n"); grid = -1; return; }
        if (hipOccupancyMaxActiveBlocksPerMultiprocessor(&per_cu, (const void*)hymba_fwd, 512, LDS_BYTES) != hipSuccess || per_cu < 1) { fprintf(stderr, "kernel_launch: occupancy query gave %d\n", per_cu); per_cu = 1; }
        (void)hipGetLastError();
        grid = cus * 1;
        if (grid <= 0) grid = 256;
    }
    if (grid < 0) return;
    Params p{};
    for (int i = 0; i < 17; ++i) p.in[i] = (const float*)d_in[i];
    p.out = (float*)d_out; p.ws = (unsigned char*)d_ws;
    void* args[] = {&p};
    hipError_t e = hipLaunchCooperativeKernel((const void*)hymba_fwd, dim3(grid), dim3(512), args, LDS_BYTES, stream);
    if (e != hipSuccess) fprintf(stderr, "cooperative launch failed: %s (grid %d)\n", hipGetErrorString(e), grid);
}
```

```cpp
#include <hip/hip_runtime.h>
#include <hip/hip_cooperative_groups.h>
#include <cstdio>
#include <cstdint>
namespace cg = cooperative_groups;
#ifndef DUP_ATTN
#define DUP_ATTN 1
#endif
#ifndef DUP_MISC
#define DUP_MISC 1
#endif

namespace pg8 {
#define PG8_LAS __attribute__((address_space(3)))
typedef unsigned short bf16_t;
typedef short bf16x8 __attribute__((ext_vector_type(8)));
typedef float f32x4 __attribute__((ext_vector_type(4)));
typedef unsigned u32x4 __attribute__((ext_vector_type(4)));
constexpr int BM = 256, BK = 64, HALF = 128, HTB = HALF * BK * 2  , STAGE_BYTES = 8 * HTB, NXCD = 8, WGM = 8;

__host__ __device__ __forceinline__ int lds_byte(int r, int c) { const int st = (r >> 4) * 2 + (c >> 5), rr = r & 15, cc = c & 31, ob = rr * 64 + cc * 2; return st * 1024 + (ob ^ (((ob >> 9) & 1) << 5)); }
__host__ __device__ __forceinline__ void stage_rc(int b, int& R, int& C) { const int st = b / 1024, sb = b % 1024, swz = sb ^ (((sb >> 9) & 1) << 5); R = (st >> 1) * 16 + swz / 64; C = (st & 1) * 32 + (swz % 64) / 2; }
__host__ __device__ __forceinline__ int perm32(int rho) { const int n = rho >> 4, i = rho & 15; return 8 * (i >> 2) + 4 * n + (i & 3); }

struct Unit { int pm, pn, kind; };
struct Gemm { const bf16_t *A0, *A1, *B0, *B1; int K; };

__device__ __forceinline__ void tile_map(int L, int nM, int nN, int& pm, int& pn) {
    const int nwg = nM * nN; int wgid = L;
    { const int q = nwg / NXCD, r = nwg % NXCD, xcd = wgid % NXCD, off = wgid / NXCD; wgid = (xcd < r ? xcd * (q + 1) : r * (q + 1) + (xcd - r) * q) + off; }
    const int nig = WGM * nN, gid = wgid / nig, fm = gid * WGM, gsz = (nM - fm) < WGM ? (nM - fm) : WGM;
    pm = fm + ((wgid % nig) % gsz); pn = (wgid % nig) / gsz;
}
struct DualOrder {
    int nM0, nN0, nM1, nN1, G, c;
    __device__ __forceinline__ bool next(int i, Unit& u) const {
        const int L = i * G + c; const int n0 = nM0 * nN0, n1 = nM1 * nN1;
        if (L < n0) { tile_map(L, nM0, nN0, u.pm, u.pn); u.kind = 0; return true; }
        if (L < n0 + n1) { tile_map(L - n0, nM1, nN1, u.pm, u.pn); u.kind = 1; return true; }
        return false;
    }
    __device__ __forceinline__ void a_ready(const Unit&) const {}
    __device__ __forceinline__ void done(const Unit&) const {}
};

__device__ __forceinline__ unsigned cvt_pk_bf16(float lo, float hi) { unsigned r; asm volatile("v_cvt_pk_bf16_f32 %0, %1, %2" : "=v"(r) : "v"(lo), "v"(hi)); return r; }

constexpr float RMS_EPS = 1e-6f;
struct EpiScale {
    static constexpr bool PERM = true, AFTER_DRAIN = false;
    bf16_t* O0; int ld0; bf16_t* O1; int ld1; const float* ss; float invn;
    __device__ __forceinline__ void operator()(const f32x4 (&acc)[2][2][4][2], const Unit& u, int wr, int wc, int fr, int fq) const {
        const int row0 = u.pm * BM + wr * 64 + fr, col0 = u.pn * BM + wc * 32 + 8 * fq;
        if (u.kind == 0) {
#pragma unroll
            for (int ai = 0; ai < 2; ++ai)
#pragma unroll
                for (int m = 0; m < 4; ++m) { const int r = row0 + ai * HALF + m * 16; const float rs = __builtin_amdgcn_rsqf(ss[r] * invn + RMS_EPS);
                    bf16_t* rowp = O0 + (size_t)r * ld0 + col0;
#pragma unroll
                    for (int bj = 0; bj < 2; ++bj) { const f32x4 v0 = acc[ai][bj][m][0] * rs, v1 = acc[ai][bj][m][1] * rs;
                        u32x4 w; w.x = cvt_pk_bf16(v0[0], v0[1]); w.y = cvt_pk_bf16(v0[2], v0[3]); w.z = cvt_pk_bf16(v1[0], v1[1]); w.w = cvt_pk_bf16(v1[2], v1[3]);
                        *(u32x4*)(rowp + bj * HALF) = w; } }
        } else {
            f32x4 rsv[2][2];
#pragma unroll
            for (int bj = 0; bj < 2; ++bj)
#pragma unroll
                for (int n = 0; n < 2; ++n) { const f32x4 s4 = *(const f32x4*)(ss + col0 + bj * HALF + 4 * n);
#pragma unroll
                    for (int e = 0; e < 4; ++e) rsv[bj][n][e] = __builtin_amdgcn_rsqf(s4[e] * invn + RMS_EPS); }
#pragma unroll
            for (int ai = 0; ai < 2; ++ai)
#pragma unroll
                for (int m = 0; m < 4; ++m) { const int r = row0 + ai * HALF + m * 16; bf16_t* rowp = O1 + (size_t)r * ld1 + col0;
#pragma unroll
                    for (int bj = 0; bj < 2; ++bj) { const f32x4 v0 = acc[ai][bj][m][0] * rsv[bj][0], v1 = acc[ai][bj][m][1] * rsv[bj][1];
                        u32x4 w; w.x = cvt_pk_bf16(v0[0], v0[1]); w.y = cvt_pk_bf16(v0[2], v0[3]); w.z = cvt_pk_bf16(v1[0], v1[1]); w.w = cvt_pk_bf16(v1[2], v1[3]);
                        *(u32x4*)(rowp + bj * HALF) = w; } }
        }
    }
};
struct EpiResid {
    static constexpr bool PERM = true, AFTER_DRAIN = false;
    const float* xold; float* xnew; bf16_t* xb; float* ssout;
    __device__ __forceinline__ void operator()(const f32x4 (&acc)[2][2][4][2], const Unit& u, int wr, int wc, int fr, int fq) const {
        const int row0 = u.pm * BM + wr * 64 + fr, col0 = u.pn * BM + wc * 32 + 8 * fq;
#pragma unroll
        for (int ai = 0; ai < 2; ++ai)
#pragma unroll
            for (int m = 0; m < 4; ++m) { const int r = row0 + ai * HALF + m * 16; const size_t off = (size_t)r * 2048 + col0; float part = 0.f;
#pragma unroll
                for (int bj = 0; bj < 2; ++bj) { const f32x4 o0 = *(const f32x4*)(xold + off + bj * HALF), o1 = *(const f32x4*)(xold + off + bj * HALF + 4);
                    const f32x4 v0 = o0 + acc[ai][bj][m][0], v1 = o1 + acc[ai][bj][m][1];
                    *(f32x4*)(xnew + off + bj * HALF) = v0; *(f32x4*)(xnew + off + bj * HALF + 4) = v1;
                    u32x4 w; w.x = cvt_pk_bf16(v0[0], v0[1]); w.y = cvt_pk_bf16(v0[2], v0[3]); w.z = cvt_pk_bf16(v1[0], v1[1]); w.w = cvt_pk_bf16(v1[2], v1[3]);
                    *(u32x4*)(xb + off + bj * HALF) = w;
                    part += (v0[0] * v0[0] + v0[1] * v0[1]) + (v0[2] * v0[2] + v0[3] * v0[3]) + (v1[0] * v1[0] + v1[1] * v1[1]) + (v1[2] * v1[2] + v1[3] * v1[3]); }
                part += __shfl_xor(part, 16); part += __shfl_xor(part, 32);
                if (ssout != nullptr && fq == 0) atomicAdd(ssout + r, part); }
    }
};

template <class Epi, class Sched, bool ALIGN_EPI = false, bool SP2 = false>
__device__ __forceinline__ void gemm_phase(PG8_LAS unsigned char* lds, const Gemm g, const Sched& S, const Epi& E) {
    int tid = threadIdx.x; asm volatile("" : "+v"(tid)); const int wid = __builtin_amdgcn_readfirstlane(tid >> 6), lane = tid & 63, wr = wid >> 2, wc = wid & 3, fr = lane & 15, fq = lane >> 4;
    int K = g.K; asm volatile("" : "+s"(K)); const int nt = K / BK;
    unsigned voffA[2], voffB[2];
#pragma unroll
    for (int i = 0; i < 2; ++i) { int R, C; stage_rc(tid * 16 + i * 8192, R, C); const int Rb = Epi::PERM ? ((R & ~31) + perm32(R & 31)) : R;
        voffA[i] = (unsigned)(R * K + C) * 2u; voffB[i] = (unsigned)(Rb * K + C) * 2u; }
    const size_t kstep = (size_t)(BK * 2);
    const size_t hstep = (size_t)HALF * K * 2;
    const size_t tstep = 2 * hstep;
    const unsigned ldsw = (unsigned)wid * 1024u;
    const int aoff = lds_byte(wr * 64 + fr, fq * 8), boff = lds_byte(wc * 32 + fr, fq * 8);
#define PG8_SA(b, h) (((b) * 2 + (h)) * HTB)
#define PG8_SB(b, h) ((4 + (b) * 2 + (h)) * HTB)
#define PG8_STAGE(bufoff, gbase, voff) do { _Pragma("unroll") for (int _i = 0; _i < 2; ++_i) \
        __builtin_amdgcn_global_load_lds((const unsigned*)((const char*)(gbase) + (voff)[_i]), (PG8_LAS unsigned*)(lds + (bufoff) + ldsw + _i * 8192), 16, 0, 0); } while (0)
#define PG8_LDA(dst, b, h) do { _Pragma("unroll") for (int m = 0; m < 4; ++m) _Pragma("unroll") for (int k = 0; k < 2; ++k) dst[m][k] = *(const PG8_LAS bf16x8*)(lds + PG8_SA(b, h) + aoff + m * 2048 + k * 1024); } while (0)
#define PG8_LDB(dst, b, h) do { _Pragma("unroll") for (int n = 0; n < 2; ++n) _Pragma("unroll") for (int k = 0; k < 2; ++k) dst[n][k] = *(const PG8_LAS bf16x8*)(lds + PG8_SB(b, h) + boff + n * 2048 + k * 1024); } while (0)
#define PG8_MMA(ai, bj, At, Bt) do { __builtin_amdgcn_s_setprio(1); _Pragma("unroll") for (int m = 0; m < 4; ++m) _Pragma("unroll") for (int n = 0; n < 2; ++n) _Pragma("unroll") for (int k = 0; k < 2; ++k) \
        acc[ai][bj][m][n] = __builtin_amdgcn_mfma_f32_16x16x32_bf16(Bt[n][k], At[m][k], acc[ai][bj][m][n], 0, 0, 0); __builtin_amdgcn_s_setprio(0); } while (0)
#define PG8_WAIT_V(n) asm volatile("s_waitcnt vmcnt(" #n ")" ::: "memory")
#define PG8_WAIT_L(n) asm volatile("s_waitcnt lgkmcnt(" #n ")" ::: "memory")
#define PG8_BAR __builtin_amdgcn_s_barrier()
#define PG8_SCHED __builtin_amdgcn_sched_barrier(0)
    Unit cur, nxt; int ui = 0;
    if (!S.next(0, cur)) return;
    f32x4 acc[2][2][4][2];
#pragma unroll
    for (int a = 0; a < 2; ++a)
#pragma unroll
        for (int b = 0; b < 2; ++b)
#pragma unroll
            for (int m = 0; m < 4; ++m)
#pragma unroll
                for (int n = 0; n < 2; ++n) acc[a][b][m][n] = (f32x4){0.f, 0.f, 0.f, 0.f};
    bf16x8 At[4][2], B0[2][2], B1[2][2];
    const char* cA = (const char*)(cur.kind ? g.A1 : g.A0) + (size_t)cur.pm * tstep; const char* cB = (const char*)(cur.kind ? g.B1 : g.B0) + (size_t)cur.pn * tstep;
    S.a_ready(cur);
    if constexpr (SP2) {
        PG8_STAGE(PG8_SB(0, 0), cB, voffB); PG8_STAGE(PG8_SB(0, 1), cB + hstep, voffB); PG8_STAGE(PG8_SA(0, 0), cA, voffA); PG8_STAGE(PG8_SA(0, 1), cA + hstep, voffA);
        if (wr == 1) PG8_BAR;
        PG8_WAIT_V(2); PG8_BAR;
        PG8_STAGE(PG8_SB(1, 0), cB + kstep, voffB); PG8_STAGE(PG8_SA(1, 0), cA + kstep, voffA); PG8_STAGE(PG8_SB(1, 1), cB + hstep + kstep, voffB);
        PG8_WAIT_V(6); PG8_BAR;
    } else {
        PG8_STAGE(PG8_SB(0, 0), cB, voffB); PG8_STAGE(PG8_SA(0, 0), cA, voffA); PG8_STAGE(PG8_SB(0, 1), cB + hstep, voffB); PG8_STAGE(PG8_SA(0, 1), cA + hstep, voffA);
        if (wr == 1) PG8_BAR;
        PG8_WAIT_V(4); PG8_BAR;
        PG8_STAGE(PG8_SB(1, 0), cB + kstep, voffB); PG8_STAGE(PG8_SA(1, 0), cA + kstep, voffA); PG8_STAGE(PG8_SB(1, 1), cB + hstep + kstep, voffB);
        PG8_WAIT_V(6); PG8_BAR;
    }
    for (;;) {
        const bool has_next = S.next(ui + 1, nxt);
        const char* nA = has_next ? (const char*)(nxt.kind ? g.A1 : g.A0) + (size_t)nxt.pm * tstep : cA; const char* nB = has_next ? (const char*)(nxt.kind ? g.B1 : g.B0) + (size_t)nxt.pn * tstep : cB;
        for (int t = 0; t < nt; t += 2) {
            const bool last = (t == nt - 2);
            const char* a1 = cA + (size_t)(t + 1) * kstep;
            const char* a2 = last ? nA : cA + (size_t)(t + 2) * kstep; const char* b2 = last ? nB : cB + (size_t)(t + 2) * kstep;
            const char* a3 = a2 + kstep; const char* b3 = b2 + kstep;
            if (last && has_next) S.a_ready(nxt);
            if constexpr (SP2) {
            PG8_LDB(B0, 0, 0); PG8_LDB(B1, 0, 1); PG8_SCHED; PG8_LDA(At, 0, 0); PG8_STAGE(PG8_SA(1, 1), a1 + hstep, voffA);
            PG8_WAIT_V(8); PG8_WAIT_L(0); PG8_BAR; PG8_MMA(0, 0, At, B0); PG8_MMA(0, 1, At, B1); PG8_BAR; PG8_SCHED;
            PG8_LDA(At, 0, 1); PG8_STAGE(PG8_SB(0, 0), b2, voffB); PG8_STAGE(PG8_SB(0, 1), b2 + hstep, voffB); PG8_STAGE(PG8_SA(0, 0), a2, voffA);
            PG8_WAIT_V(8); PG8_WAIT_L(0); PG8_BAR; PG8_MMA(1, 0, At, B0); PG8_MMA(1, 1, At, B1); PG8_BAR; PG8_SCHED;
            PG8_LDB(B0, 1, 0); PG8_LDB(B1, 1, 1); PG8_SCHED; PG8_LDA(At, 1, 0); PG8_STAGE(PG8_SA(0, 1), a2 + hstep, voffA);
            PG8_WAIT_V(8); PG8_WAIT_L(0); PG8_BAR; PG8_MMA(0, 0, At, B0); PG8_MMA(0, 1, At, B1); PG8_BAR; PG8_SCHED;
            PG8_LDA(At, 1, 1); PG8_STAGE(PG8_SB(1, 0), b3, voffB); PG8_STAGE(PG8_SB(1, 1), b3 + hstep, voffB); PG8_STAGE(PG8_SA(1, 0), a3, voffA);
            PG8_WAIT_V(8); PG8_WAIT_L(0); PG8_BAR; PG8_MMA(1, 0, At, B0); PG8_MMA(1, 1, At, B1); PG8_BAR; PG8_SCHED;
            } else {
            PG8_LDB(B0, 0, 0); PG8_SCHED; PG8_LDA(At, 0, 0); PG8_STAGE(PG8_SA(1, 1), a1 + hstep, voffA);
            PG8_WAIT_L(8); PG8_BAR; PG8_WAIT_L(0); PG8_MMA(0, 0, At, B0); PG8_BAR; PG8_SCHED;
            PG8_LDB(B1, 0, 1); PG8_STAGE(PG8_SB(0, 0), b2, voffB);
            PG8_BAR; PG8_WAIT_L(0); PG8_MMA(0, 1, At, B1); PG8_BAR;
            PG8_LDA(At, 0, 1); PG8_STAGE(PG8_SA(0, 0), a2, voffA);
            PG8_BAR; PG8_WAIT_L(0); PG8_MMA(1, 0, At, B0); PG8_BAR; PG8_SCHED;
            PG8_STAGE(PG8_SB(0, 1), b2 + hstep, voffB);
            PG8_WAIT_V(6); PG8_BAR; PG8_MMA(1, 1, At, B1); PG8_BAR;
            PG8_LDB(B0, 1, 0); PG8_SCHED; PG8_LDA(At, 1, 0); PG8_STAGE(PG8_SA(0, 1), a2 + hstep, voffA);
            PG8_WAIT_L(8); PG8_BAR; PG8_WAIT_L(0); PG8_MMA(0, 0, At, B0); PG8_BAR; PG8_SCHED;
            PG8_LDB(B1, 1, 1); PG8_STAGE(PG8_SB(1, 0), b3, voffB);
            PG8_BAR; PG8_WAIT_L(0); PG8_MMA(0, 1, At, B1); PG8_BAR;
            PG8_LDA(At, 1, 1); PG8_STAGE(PG8_SA(1, 0), a3, voffA);
            PG8_BAR; PG8_WAIT_L(0); PG8_MMA(1, 0, At, B0); PG8_BAR; PG8_SCHED;
            PG8_STAGE(PG8_SB(1, 1), b3 + hstep, voffB);
            PG8_WAIT_V(6); PG8_BAR; PG8_MMA(1, 1, At, B1); PG8_BAR;
            }
        }
        if constexpr (ALIGN_EPI) { if (wr == 0) PG8_BAR; }
        if constexpr (!Epi::AFTER_DRAIN) { E(acc, cur, wr, wc, fr, fq); S.done(cur); }
        if (!has_next) break;
#pragma unroll
        for (int a = 0; a < 2; ++a)
#pragma unroll
            for (int b = 0; b < 2; ++b)
#pragma unroll
                for (int m = 0; m < 4; ++m)
#pragma unroll
                    for (int n = 0; n < 2; ++n) acc[a][b][m][n] = (f32x4){0.f, 0.f, 0.f, 0.f};
        cur = nxt; cA = nA; cB = nB; ++ui;
        if constexpr (ALIGN_EPI) { if (wr == 1) PG8_BAR; }
    }
    PG8_WAIT_V(0);
    if constexpr (!ALIGN_EPI) { if (wr == 0) PG8_BAR; }
    PG8_BAR;
    if constexpr (Epi::AFTER_DRAIN) { E.fused(acc, cur, wr, wc, fr, fq, lds, wid, lane); S.done(cur); }
#undef PG8_SA
#undef PG8_SB
#undef PG8_STAGE
#undef PG8_LDA
#undef PG8_LDB
#undef PG8_MMA
#undef PG8_WAIT_V
#undef PG8_WAIT_L
#undef PG8_BAR
#undef PG8_SCHED
}
}

#define LAS __attribute__((address_space(3)))
typedef unsigned short bf16;
typedef unsigned v4u __attribute__((ext_vector_type(4)));
typedef unsigned v2u __attribute__((ext_vector_type(2)));
typedef float f32x4 __attribute__((ext_vector_type(4)));
typedef float f32x2 __attribute__((ext_vector_type(2)));
typedef short bf16x8 __attribute__((ext_vector_type(8)));

constexpr int T = 16384, SEQ = 4096, DM = 2048, NPT = 3840, NCT = 2304, NCC = 1280, DFF = 5632, NUP = 11264, INC = 5648;
constexpr float EPS = 1e-6f;
constexpr int PT_Q = 0, PT_K = 1024, PT_Z = 2048, PT_BM = 3072, PT_CM = 3328, PT_DT = 3584;
constexpr size_t SZ_WA = (size_t)NPT * DM * 2, SZ_WB = (size_t)NCT * DM * 2, SZ_WOUT = (size_t)DM * DM * 2, SZ_WUP = (size_t)NUP * DM * 2, SZ_WDOWN = (size_t)DM * DFF * 2;
constexpr size_t OFF_WA = 0, OFF_WB = OFF_WA + SZ_WA, OFF_WOUT = OFF_WB + SZ_WB, OFF_WUP = OFF_WOUT + SZ_WOUT, OFF_WDOWN = OFF_WUP + SZ_WUP;
constexpr size_t OFF_XB = OFF_WDOWN + SZ_WDOWN;
constexpr size_t OFF_SMALL = OFF_XB + (size_t)T * DM * 2;
constexpr size_t OFF_DT = OFF_SMALL, OFF_ACUM = OFF_DT + (1u << 20), OFF_CDEC = OFF_ACUM + (1u << 20), OFF_KMEAN = OFF_CDEC + 65536, OFF_SS = OFF_KMEAN + 262144;
constexpr size_t OFF_BIG = OFF_SMALL + (4u << 20);
constexpr size_t OFF_PT = OFF_BIG, OFF_CT = OFF_PT + (size_t)T * NPT * 2, OFF_CC = OFF_CT + (size_t)NCT * T * 2, OFF_BMCM = OFF_CC + (size_t)NCC * T * 2;
constexpr size_t OFF_MIX = OFF_BMCM + (size_t)T * 512 * 2, OFF_STATES = OFF_MIX + (size_t)T * DM * 2, OFF_HIN = OFF_STATES + (size_t)2048 * 8192 * 4, OFF_END1 = OFF_HIN + (size_t)2048 * 8192 * 2;
constexpr size_t OFF_U = OFF_BIG, OFF_G = OFF_U + (size_t)T * NUP * 2, OFF_END2 = OFF_G + (size_t)T * DFF * 2;
constexpr size_t WS_NEED = OFF_END2 > OFF_END1 ? OFF_END2 : OFF_END1;
static_assert(WS_NEED <= 738197504ull, "workspace");
static_assert(OFF_SS + 4 * T * 4 <= OFF_BIG, "small region");
constexpr int LDS_BYTES = 147456;

struct Params { const float* in[17]; float* out; unsigned char* ws; };

__device__ __forceinline__ float bflo(unsigned u) { return __uint_as_float(u << 16); }
__device__ __forceinline__ float bfhi(unsigned u) { return __uint_as_float(u & 0xffff0000u); }
__device__ __forceinline__ float bf1(bf16 b) { return __uint_as_float(((unsigned)b) << 16); }
__device__ __forceinline__ unsigned pk2(float lo, float hi) { return pg8::cvt_pk_bf16(lo, hi); }
__device__ __forceinline__ float silu_f(float x) { return x / (1.f + __expf(-x)); }
__device__ __forceinline__ float wave_sum(float v) {
#pragma unroll
    for (int o = 1; o < 64; o <<= 1) v += __shfl_xor(v, o);
    return v;
}
__device__ __forceinline__ float wave_max(float v) {
#pragma unroll
    for (int o = 1; o < 64; o <<= 1) v = fmaxf(v, __shfl_xor(v, o));
    return v;
}
__device__ __forceinline__ int fresh_tid() { int t = threadIdx.x; asm volatile("" : "+v"(t)); return t; }
__device__ __forceinline__ int fresh_bid() { int t = blockIdx.x; asm volatile("" : "+s"(t)); return t; }
#define MFMA16(a, b, c) __builtin_amdgcn_mfma_f32_16x16x32_bf16((a), (b), (c), 0, 0, 0)

__device__ __forceinline__ void transpose_item(const float* W, int N, int ncol0, int nvalid, const float* kscale, bf16* WT, int K, int kb, int nb, LAS float* scr, int lane) {
    const int k0 = 64 * kb, n0 = 64 * nb, n4 = (lane & 15) * 4, kr = lane >> 4; const bool ok = (n0 + n4) < nvalid;
    f32x4 v[16];
#pragma unroll
    for (int i = 0; i < 16; ++i) { v[i] = (f32x4){0.f, 0.f, 0.f, 0.f}; if (ok) v[i] = *(const f32x4*)(W + (size_t)(k0 + 4 * i + kr) * N + ncol0 + n0 + n4); }
    if (kscale) {
#pragma unroll
        for (int i = 0; i < 16; ++i) v[i] = v[i] * kscale[k0 + 4 * i + kr]; }
#pragma unroll
    for (int i = 0; i < 16; ++i) { LAS float* d = scr + (4 * i + kr) * 65 + n4; d[0] = v[i][0]; d[1] = v[i][1]; d[2] = v[i][2]; d[3] = v[i][3]; }
    asm volatile("s_waitcnt lgkmcnt(0)" ::: "memory");
    const int c = lane & 7;
#pragma unroll
    for (int jj = 0; jj < 8; ++jj) { const int n = (lane >> 3) + 8 * jj; const LAS float* sp = scr + (8 * c) * 65 + n;
        v4u o; o.x = pk2(sp[0 * 65], sp[1 * 65]); o.y = pk2(sp[2 * 65], sp[3 * 65]); o.z = pk2(sp[4 * 65], sp[5 * 65]); o.w = pk2(sp[6 * 65], sp[7 * 65]);
        *(v4u*)(WT + (size_t)(n0 + n) * K + k0 + 8 * c) = o; }
    asm volatile("s_waitcnt lgkmcnt(0)" ::: "memory");
}
__device__ __forceinline__ void convert_jobs(const Params& P, int layer, int jlo, int jhi, LAS unsigned char* lds) {
    unsigned char* ws = P.ws; const int tid_ = fresh_tid(); const int lane = tid_ & 63, wave_ = __builtin_amdgcn_readfirstlane(tid_ >> 6); const int gw = fresh_bid() * 8 + wave_, NGW = gridDim.x * 8; LAS float* scr = (LAS float*)lds + wave_ * (64 * 65);
    const float* w_in = P.in[2] + (size_t)layer * DM * INC; const float* n1 = P.in[1] + layer * DM; const float* n2 = P.in[12] + layer * DM;
    for (int j = jlo; j < jhi; ++j) {
        const float* W; int N, ncol0, nvalid, nrows, K; const float* ks; bf16* dst;
        if (j == 0)      { W = w_in; N = INC; ncol0 = 0;    nvalid = 2048; nrows = 2048; K = DM; ks = n1; dst = (bf16*)(ws + OFF_WA); }
        else if (j == 1) { W = w_in; N = INC; ncol0 = 3072; nvalid = 1024; nrows = 1024; K = DM; ks = n1; dst = (bf16*)(ws + OFF_WA) + (size_t)2048 * DM; }
        else if (j == 2) { W = w_in; N = INC; ncol0 = 5120; nvalid = 528;  nrows = 768;  K = DM; ks = n1; dst = (bf16*)(ws + OFF_WA) + (size_t)3072 * DM; }
        else if (j == 3) { W = w_in; N = INC; ncol0 = 2048; nvalid = 1024; nrows = 1024; K = DM; ks = n1; dst = (bf16*)(ws + OFF_WB); }
        else if (j == 4) { W = w_in; N = INC; ncol0 = 4096; nvalid = 1280; nrows = 1280; K = DM; ks = n1; dst = (bf16*)(ws + OFF_WB) + (size_t)1024 * DM; }
        else if (j == 5) { W = P.in[11] + (size_t)layer * DM * DM; N = DM; ncol0 = 0; nvalid = DM; nrows = DM; K = DM; ks = nullptr; dst = (bf16*)(ws + OFF_WOUT); }
        else if (j == 6) { W = P.in[13] + (size_t)layer * DM * NUP; N = NUP; ncol0 = 0; nvalid = NUP; nrows = NUP; K = DM; ks = n2; dst = (bf16*)(ws + OFF_WUP); }
        else             { W = P.in[16] + (size_t)layer * DFF * DM; N = DM; ncol0 = 0; nvalid = DM; nrows = DM; K = DFF; ks = nullptr; dst = (bf16*)(ws + OFF_WDOWN); }
        const int nnb = nrows / 64, nitems = (K / 64) * nnb;
        for (int it = gw; it < nitems; it += NGW) transpose_item(W, N, ncol0, nvalid, ks, dst, K, it / nnb, it % nnb, scr, lane);
    }
}

__device__ __forceinline__ void phase_x0(const Params& P) {
    const int tid_ = fresh_tid(); const int lane = tid_ & 63; const int gw = fresh_bid() * 8 + __builtin_amdgcn_readfirstlane(tid_ >> 6), NGW = gridDim.x * 8;
    const float* x = P.in[0]; bf16* xb = (bf16*)(P.ws + OFF_XB); float* ss = (float*)(P.ws + OFF_SS);
    for (int m = gw; m < T; m += NGW) {
        const f32x4* xr = (const f32x4*)(x + (size_t)m * DM) + lane; v2u* o = (v2u*)(xb + (size_t)m * DM) + lane; float s = 0.f;
#pragma unroll
        for (int j = 0; j < 8; ++j) { const f32x4 v = xr[64 * j]; s += (v[0] * v[0] + v[1] * v[1]) + (v[2] * v[2] + v[3] * v[3]); v2u w; w.x = pk2(v[0], v[1]); w.y = pk2(v[2], v[3]); o[64 * j] = w; }
        s = wave_sum(s); if (lane == 0) ss[m] = s;
    }
    const int gt = fresh_bid() * 512 + fresh_tid(), NT = gridDim.x * 512;
    for (int i = gt; i < 3 * T; i += NT) ss[T + i] = 0.f;
}

__device__ __forceinline__ void knorm_unit(const Params& P, int layer, int ku, LAS unsigned char* lds) {
    const int tid = fresh_tid(); const int b = ku >> 7, blk = (ku >> 3) & 15, h = ku & 7;
    bf16* PT = (bf16*)(P.ws + OFF_PT); float* kmean = (float*)(P.ws + OFF_KMEAN); const float* kw = P.in[4] + layer * 128;
    const int row = tid >> 1, half = tid & 1; const int t = b * SEQ + blk * 256 + row;
    bf16* kp = PT + (size_t)t * NPT + PT_K + h * 128 + half * 64;
    v4u raw[8]; float ss = 0.f;
#pragma unroll
    for (int j = 0; j < 8; ++j) { raw[j] = *(const v4u*)(kp + 8 * j);
#pragma unroll
        for (int e = 0; e < 4; ++e) { const float a = bflo(raw[j][e]), c = bfhi(raw[j][e]); ss += a * a + c * c; } }
    ss += __shfl_xor(ss, 1);
    const float rs = __builtin_amdgcn_rsqf(ss * (1.f / 128.f) + EPS);
    LAS bf16* lk = (LAS bf16*)lds;
#pragma unroll
    for (int j = 0; j < 8; ++j) { const f32x4 w0 = *(const f32x4*)(kw + half * 64 + 8 * j), w1 = *(const f32x4*)(kw + half * 64 + 8 * j + 4); v4u o;
        o.x = pk2(bflo(raw[j].x) * rs * w0[0], bfhi(raw[j].x) * rs * w0[1]); o.y = pk2(bflo(raw[j].y) * rs * w0[2], bfhi(raw[j].y) * rs * w0[3]);
        o.z = pk2(bflo(raw[j].z) * rs * w1[0], bfhi(raw[j].z) * rs * w1[1]); o.w = pk2(bflo(raw[j].w) * rs * w1[2], bfhi(raw[j].w) * rs * w1[3]);
        *(v4u*)(kp + 8 * j) = o; *(LAS v4u*)(lk + row * 128 + half * 64 + 8 * j) = o; }
    __syncthreads();
    LAS float* lp = (LAS float*)(lds + 65536);
    { const int c = tid & 127, part = tid >> 7; float s = 0.f;
#pragma unroll 8
      for (int i = 0; i < 64; ++i) s += bf1(lk[(part * 64 + i) * 128 + c]);
      lp[part * 128 + c] = s; }
    __syncthreads();
    if (tid < 128) kmean[((size_t)(b * 8 + h) * 16 + blk) * 128 + tid] = (lp[tid] + lp[128 + tid] + lp[256 + tid] + lp[384 + tid]) * (1.f / 256.f);
    __syncthreads();
}

__device__ __forceinline__ void ssd_prep_unit(const Params& P, int layer, int su, LAS unsigned char* lds) {
    const int tid = fresh_tid(), lane = tid & 63, wave = tid >> 6; const int b = su >> 6, c = (su >> 1) & 31, g = su & 1;
    const int t0 = b * SEQ + c * 128, s0 = c * 128;
    unsigned char* ws = P.ws; const bf16* PT = (const bf16*)(ws + OFF_PT); const bf16* CT = (const bf16*)(ws + OFF_CT); bf16* CC = (bf16*)(ws + OFF_CC); bf16* BMCM = (bf16*)(ws + OFF_BMCM);
    float* DTt = (float*)(ws + OFF_DT); float* ACt = (float*)(ws + OFF_ACUM); float* CDEC = (float*)(ws + OFF_CDEC); float* STATES = (float*)(ws + OFF_STATES);
    const float* cw = P.in[5] + (size_t)layer * 4 * 1536; const float* cb = P.in[6] + layer * 1536;
    LAS float* wts = (LAS float*)lds;
    { const int hd = 8 * g + wave; const int l = 2 * lane;
      const float bias = P.in[7][layer * 16 + hd]; const float a = -__expf(P.in[8][layer * 16 + hd]);
      float v0 = bf1(PT[(size_t)(t0 + l) * NPT + PT_DT + hd]) + bias, v1 = bf1(PT[(size_t)(t0 + l + 1) * NPT + PT_DT + hd]) + bias;
      const float d0 = v0 > 20.f ? v0 : log1pf(__expf(v0)), d1 = v1 > 20.f ? v1 : log1pf(__expf(v1));
      const float la0 = d0 * a, la1 = d1 * a; float x = la0 + la1;
#pragma unroll
      for (int o = 1; o < 64; o <<= 1) { const float y = __shfl_up(x, o); if (lane >= o) x += y; }
      const float ac1 = x, ac0 = x - la1; const float tot = __shfl(x, 63);
      const size_t o2 = (size_t)(b * 16 + hd) * SEQ + s0 + l;
      *(f32x2*)(DTt + o2) = (f32x2){d0, d1}; *(f32x2*)(ACt + o2) = (f32x2){ac0, ac1};
      wts[wave * 128 + l] = d0 * __expf(tot - ac0); wts[wave * 128 + l + 1] = d1 * __expf(tot - ac1);
      if (lane == 63) CDEC[(b * 32 + c) * 16 + hd] = __expf(tot); }
    for (int it = tid; it < 640 * 16; it += 512) {
        const int row = it >> 4, sg = it & 15; int ctrow, ch, ccrow;
        if (row < 512) { ctrow = 1024 + 512 * g + row; ch = 512 * g + row; ccrow = 512 * g + row; } else { ctrow = 2048 + 128 * g + (row - 512); ch = 1024 + 128 * g + (row - 512); ccrow = 1024 + 128 * g + (row - 512); }
        const bf16* src = CT + (size_t)ctrow * T + t0 + 8 * sg;
        const v4u cur = *(const v4u*)src; v4u prev = (v4u){0u, 0u, 0u, 0u}; if (s0 + 8 * sg > 0) prev = *(const v4u*)(src - 8);
        const float w0 = cw[ch], w1 = cw[1536 + ch], w2 = cw[2 * 1536 + ch], w3 = cw[3 * 1536 + ch], bi = cb[ch];
        float xv[11]; xv[0] = bfhi(prev.z); xv[1] = bflo(prev.w); xv[2] = bfhi(prev.w);
        xv[3] = bflo(cur.x); xv[4] = bfhi(cur.x); xv[5] = bflo(cur.y); xv[6] = bfhi(cur.y); xv[7] = bflo(cur.z); xv[8] = bfhi(cur.z); xv[9] = bflo(cur.w); xv[10] = bfhi(cur.w);
        float o[8];
#pragma unroll
        for (int i = 0; i < 8; ++i) o[i] = silu_f(bi + w0 * xv[i] + w1 * xv[i + 1] + w2 * xv[i + 2] + w3 * xv[i + 3]);
        v4u ov; ov.x = pk2(o[0], o[1]); ov.y = pk2(o[2], o[3]); ov.z = pk2(o[4], o[5]); ov.w = pk2(o[6], o[7]);
        *(v4u*)(CC + (size_t)ccrow * T + t0 + 8 * sg) = ov;
    }
    { const int cgp = tid & 31, run = tid >> 5; int ptcol, ch0, ocol;
      if (cgp < 16) { ptcol = PT_BM + 128 * g + 8 * cgp; ch0 = 1024 + 128 * g + 8 * cgp; ocol = 128 * g + 8 * cgp; } else { ptcol = PT_CM + 128 * g + 8 * (cgp - 16); ch0 = 1280 + 128 * g + 8 * (cgp - 16); ocol = 256 + 128 * g + 8 * (cgp - 16); }
      float w[4][8], bi[8];
#pragma unroll
      for (int k = 0; k < 4; ++k) { const f32x4 a = *(const f32x4*)(cw + k * 1536 + ch0), bq = *(const f32x4*)(cw + k * 1536 + ch0 + 4);
#pragma unroll
          for (int e = 0; e < 4; ++e) { w[k][e] = a[e]; w[k][4 + e] = bq[e]; } }
      { const f32x4 a = *(const f32x4*)(cb + ch0), bq = *(const f32x4*)(cb + ch0 + 4);
#pragma unroll
        for (int e = 0; e < 4; ++e) { bi[e] = a[e]; bi[4 + e] = bq[e]; } }
      float x1[8], x2[8], x3[8];
      const int sb = s0 + 8 * run;
#define HALO_ROW(k, d) do { v4u r_ = (v4u){0u, 0u, 0u, 0u}; if (sb - (k) >= 0) r_ = *(const v4u*)(PT + (size_t)(t0 + 8 * run - (k)) * NPT + ptcol); \
          _Pragma("unroll") for (int e = 0; e < 4; ++e) { d[2 * e] = bflo(r_[e]); d[2 * e + 1] = bfhi(r_[e]); } } while (0)
      HALO_ROW(1, x1); HALO_ROW(2, x2); HALO_ROW(3, x3);
#undef HALO_ROW
#pragma unroll
      for (int i = 0; i < 8; ++i) { const v4u r = *(const v4u*)(PT + (size_t)(t0 + 8 * run + i) * NPT + ptcol); float x0[8], o[8];
#pragma unroll
          for (int e = 0; e < 4; ++e) { x0[2 * e] = bflo(r[e]); x0[2 * e + 1] = bfhi(r[e]); }
#pragma unroll
          for (int e = 0; e < 8; ++e) { o[e] = silu_f(bi[e] + w[0][e] * x3[e] + w[1][e] * x2[e] + w[2][e] * x1[e] + w[3][e] * x0[e]); x3[e] = x2[e]; x2[e] = x1[e]; x1[e] = x0[e]; }
          v4u ov; ov.x = pk2(o[0], o[1]); ov.y = pk2(o[2], o[3]); ov.z = pk2(o[4], o[5]); ov.w = pk2(o[6], o[7]);
          *(v4u*)(BMCM + (size_t)(t0 + 8 * run + i) * 512 + ocol) = ov; } }
    __syncthreads();
    { const int hd = 8 * g + wave, i16 = lane & 15, quad = lane >> 4;
      bf16x8 Af[4][4];
#pragma unroll
      for (int pt = 0; pt < 4; ++pt)
#pragma unroll
          for (int ls = 0; ls < 4; ++ls) { const v4u r = *(const v4u*)(CC + (size_t)(512 * g + 64 * wave + 16 * pt + i16) * T + t0 + 32 * ls + 8 * quad);
              const LAS float* wp = wts + wave * 128 + 32 * ls + 8 * quad; v4u o;
              o.x = pk2(bflo(r.x) * wp[0], bfhi(r.x) * wp[1]); o.y = pk2(bflo(r.y) * wp[2], bfhi(r.y) * wp[3]); o.z = pk2(bflo(r.z) * wp[4], bfhi(r.z) * wp[5]); o.w = pk2(bflo(r.w) * wp[6], bfhi(r.w) * wp[7]);
              Af[pt][ls] = __builtin_bit_cast(bf16x8, o); }
      float* st = STATES + (size_t)((b * 32 + c) * 16 + hd) * 8192;
#pragma unroll 1
      for (int nt = 0; nt < 8; ++nt) { bf16x8 Bf[4];
#pragma unroll
          for (int ls = 0; ls < 4; ++ls) Bf[ls] = *(const bf16x8*)(CC + (size_t)(1024 + 128 * g + 16 * nt + i16) * T + t0 + 32 * ls + 8 * quad);
#pragma unroll
          for (int pt = 0; pt < 4; ++pt) { f32x4 acc = (f32x4){0.f, 0.f, 0.f, 0.f};
#pragma unroll
              for (int ls = 0; ls < 4; ++ls) acc = MFMA16(Af[pt][ls], Bf[ls], acc);
#pragma unroll
              for (int r = 0; r < 4; ++r) st[(16 * pt + 4 * quad + r) * 128 + 16 * nt + i16] = acc[r]; } } }
    __syncthreads();
}

__device__ __forceinline__ void scan_phase(const Params& P) {
    const float* STATES = (const float*)(P.ws + OFF_STATES); const float* CDEC = (const float*)(P.ws + OFF_CDEC); bf16* HIN = (bf16*)(P.ws + OFF_HIN);
    const int gt = fresh_bid() * 512 + fresh_tid(), NT = gridDim.x * 512;
    for (int item = gt; item < 64 * 2048; item += NT) { const int bh = item >> 11, e4 = (item & 2047) * 4; const int b = bh >> 4, hd = bh & 15;
        f32x4 h = (f32x4){0.f, 0.f, 0.f, 0.f};
#pragma unroll 4
        for (int c = 0; c < 32; ++c) { const size_t base = (size_t)((b * 32 + c) * 16 + hd) * 8192 + e4;
            v2u o; o.x = pk2(h[0], h[1]); o.y = pk2(h[2], h[3]); *(v2u*)(HIN + base) = o;
            const float dec = CDEC[(b * 32 + c) * 16 + hd]; const f32x4 st = *(const f32x4*)(STATES + base); h = h * dec + st; } }
}

__device__ __forceinline__ void attn_unit(const Params& P, int layer, int b, int h, int i, LAS unsigned char* lds) {
    const int tid = fresh_tid(), lane = tid & 63, w = tid >> 6, i16 = lane & 15, quad = lane >> 4;
    unsigned char* ws = P.ws; const bf16* PT = (const bf16*)(ws + OFF_PT); const bf16* CT = (const bf16*)(ws + OFF_CT); bf16* MIX = (bf16*)(ws + OFF_MIX); const float* kmean = (const float*)(ws + OFF_KMEAN);
    const float* qw = P.in[3] + layer * 128; const float* kw = P.in[4] + layer * 128;
    const float mq = wave_max(fmaxf(fabsf(qw[lane]), fabsf(qw[lane + 64]))), mk = wave_max(fmaxf(fabsf(kw[lane]), fabsf(kw[lane + 64])));
    const float C2 = 0.08838834764831845f * 1.4426950408889634f; const float Bnd = C2 * 128.f * mq * mk;
    float qf[2][32]; unsigned selmask[2];
#pragma unroll
    for (int qt = 0; qt < 2; ++qt) { const int t = b * SEQ + 256 * i + 32 * w + 16 * qt + i16; const bf16* qp = PT + (size_t)t * NPT + PT_Q + h * 128 + 8 * quad; float ss = 0.f;
#pragma unroll
        for (int s = 0; s < 4; ++s) { const v4u r = *(const v4u*)(qp + 32 * s);
#pragma unroll
            for (int e = 0; e < 4; ++e) { const float a = bflo(r[e]), c = bfhi(r[e]); qf[qt][8 * s + 2 * e] = a; qf[qt][8 * s + 2 * e + 1] = c; ss += a * a + c * c; } }
        ss += __shfl_xor(ss, 16); ss += __shfl_xor(ss, 32);
        const float rs = __builtin_amdgcn_rsqf(ss * (1.f / 128.f) + EPS);
#pragma unroll
        for (int s = 0; s < 4; ++s) { const f32x4 w0 = *(const f32x4*)(qw + 32 * s + 8 * quad), w1 = *(const f32x4*)(qw + 32 * s + 8 * quad + 4);
#pragma unroll
            for (int e = 0; e < 4; ++e) { qf[qt][8 * s + e] *= rs * w0[e]; qf[qt][8 * s + 4 + e] *= rs * w1[e]; } } }
    { float g0[16], g1[16];
#pragma unroll
      for (int j = 0; j < 16; ++j) { g0[j] = 0.f; g1[j] = 0.f;
          if (j < i) { const float* km = kmean + ((size_t)(b * 8 + h) * 16 + j) * 128 + 8 * quad; float p0 = 0.f, p1 = 0.f;
#pragma unroll
              for (int s = 0; s < 4; ++s) { const f32x4 k0 = *(const f32x4*)(km + 32 * s), k1 = *(const f32x4*)(km + 32 * s + 4);
#pragma unroll
                  for (int e = 0; e < 4; ++e) { p0 += qf[0][8 * s + e] * k0[e] + qf[0][8 * s + 4 + e] * k1[e]; p1 += qf[1][8 * s + e] * k0[e] + qf[1][8 * s + 4 + e] * k1[e]; } }
              p0 += __shfl_xor(p0, 16); p0 += __shfl_xor(p0, 32); p1 += __shfl_xor(p1, 16); p1 += __shfl_xor(p1, 32); g0[j] = p0; g1[j] = p1; } }
      unsigned m0 = 0u, m1 = 0u;
#pragma unroll
      for (int r = 0; r < 3; ++r) { float b0 = -INFINITY, b1 = -INFINITY; int i0 = -1, i1 = -1;
#pragma unroll
          for (int j = 0; j < 16; ++j) { if (j < i) { if (!((m0 >> j) & 1u) && g0[j] > b0) { b0 = g0[j]; i0 = j; } if (!((m1 >> j) & 1u) && g1[j] > b1) { b1 = g1[j]; i1 = j; } } }
          if (i0 >= 0) m0 |= 1u << i0; if (i1 >= 0) m1 |= 1u << i1; }
      selmask[0] = m0; selmask[1] = m1; }
    bf16x8 Qf[2][4];
#pragma unroll
    for (int qt = 0; qt < 2; ++qt)
#pragma unroll
        for (int s = 0; s < 4; ++s) { v4u o;
            o.x = pk2(qf[qt][8 * s + 0] * C2, qf[qt][8 * s + 1] * C2); o.y = pk2(qf[qt][8 * s + 2] * C2, qf[qt][8 * s + 3] * C2);
            o.z = pk2(qf[qt][8 * s + 4] * C2, qf[qt][8 * s + 5] * C2); o.w = pk2(qf[qt][8 * s + 6] * C2, qf[qt][8 * s + 7] * C2);
            Qf[qt][s] = __builtin_bit_cast(bf16x8, o); }
    unsigned wsel = selmask[0] | selmask[1];
#pragma unroll
    for (int o = 1; o < 64; o <<= 1) wsel |= (unsigned)__shfl_xor((int)wsel, o);
    f32x4 O[2][8]; float lsum[2] = {0.f, 0.f};
#pragma unroll
    for (int qt = 0; qt < 2; ++qt)
#pragma unroll
        for (int dt = 0; dt < 8; ++dt) O[qt][dt] = (f32x4){0.f, 0.f, 0.f, 0.f};
    const int ntiles = (i + 1) * 4;
    v4u kr[2], vr[2];
#define ATT_LOAD(n) do { const int _j = (n) >> 2, _kt = (n) & 3; const int _tk = b * SEQ + 256 * _j + 64 * _kt; \
        _Pragma("unroll") for (int _c = 0; _c < 2; ++_c) { const int cid = tid + 512 * _c; \
            kr[_c] = *(const v4u*)(PT + (size_t)(_tk + (cid >> 4)) * NPT + PT_K + h * 128 + 8 * (cid & 15)); \
            vr[_c] = *(const v4u*)(CT + (size_t)(h * 128 + (cid >> 3)) * T + _tk + 8 * (cid & 7)); } } while (0)
#define ATT_STORE(buf) do { LAS unsigned char* _kb = lds + (buf) * 32768; LAS unsigned char* _vb = _kb + 16384; \
        _Pragma("unroll") for (int _c = 0; _c < 2; ++_c) { const int cid = tid + 512 * _c; const int kr_ = cid >> 4, kc_ = cid & 15, vd_ = cid >> 3, vc_ = cid & 7; \
            *(LAS v4u*)(_kb + kr_ * 256 + 16 * (kc_ ^ ((kr_ & 3) | (((kr_ >> 3) & 3) << 2)))) = kr[_c]; \
            *(LAS v4u*)(_vb + vd_ * 128 + 16 * (vc_ ^ ((vd_ >> 1) & 7))) = vr[_c]; } } while (0)
    ATT_LOAD(0); ATT_STORE(0); __syncthreads();
#pragma unroll 1
    for (int n = 0; n < ntiles; ++n) {
        const int cur = n & 1; const int j = n >> 2, kt = n & 3; const bool own = (j == i);
        if (n + 1 < ntiles) ATT_LOAD(n + 1);
        const bool active = own ? (64 * kt <= 32 * w + 31) : (((wsel >> j) & 1u) != 0u);
        if (active) {
            const LAS unsigned char* kb = lds + cur * 32768; const LAS unsigned char* vb = kb + 16384;
#pragma unroll
            for (int kk = 0; kk < 2; ++kk) {
                const int rka = 32 * kk + 8 * (i16 >> 2) + (i16 & 3);
                bf16x8 Pf[2];
                { bf16x8 Ka[4], Kb[4];
#pragma unroll
                  for (int s = 0; s < 4; ++s) { Ka[s] = *(const LAS bf16x8*)(kb + rka * 256 + 16 * ((4 * s + quad) ^ i16)); Kb[s] = *(const LAS bf16x8*)(kb + (rka + 4) * 256 + 16 * ((4 * s + quad) ^ i16)); }
#pragma unroll
                  for (int qt = 0; qt < 2; ++qt) {
                    f32x4 Sa = (f32x4){0.f, 0.f, 0.f, 0.f}, Sb = (f32x4){0.f, 0.f, 0.f, 0.f};
#pragma unroll
                    for (int s = 0; s < 4; ++s) { Sa = MFMA16(Ka[s], Qf[qt][s], Sa); Sb = MFMA16(Kb[s], Qf[qt][s], Sb); }
                    float pa[4], pb[4]; const int qpos = 32 * w + 16 * qt + i16; const int kbase = 64 * kt + 32 * kk + 8 * quad; const bool selj = ((selmask[qt] >> j) & 1u) != 0u;
#pragma unroll
                    for (int r = 0; r < 4; ++r) { const bool va = own ? (kbase + r <= qpos) : selj, vb2 = own ? (kbase + 4 + r <= qpos) : selj;
                        pa[r] = va ? __builtin_amdgcn_exp2f(Sa[r] - Bnd) : 0.f; pb[r] = vb2 ? __builtin_amdgcn_exp2f(Sb[r] - Bnd) : 0.f; }
                    lsum[qt] += (pa[0] + pa[1]) + (pa[2] + pa[3]) + (pb[0] + pb[1]) + (pb[2] + pb[3]);
                    v4u pk; pk.x = pk2(pa[0], pa[1]); pk.y = pk2(pa[2], pa[3]); pk.z = pk2(pb[0], pb[1]); pk.w = pk2(pb[2], pb[3]);
                    Pf[qt] = __builtin_bit_cast(bf16x8, pk);
                  } }
#pragma unroll
                for (int dh = 0; dh < 2; ++dh) { bf16x8 Vf[4];
#pragma unroll
                    for (int d4 = 0; d4 < 4; ++d4) { const int d = 16 * (4 * dh + d4) + i16; Vf[d4] = *(const LAS bf16x8*)(vb + d * 128 + 16 * ((4 * kk + quad) ^ ((d >> 1) & 7))); }
#pragma unroll
                    for (int qt = 0; qt < 2; ++qt)
#pragma unroll
                        for (int d4 = 0; d4 < 4; ++d4) O[qt][4 * dh + d4] = MFMA16(Vf[d4], Pf[qt], O[qt][4 * dh + d4]);
                    asm volatile("" ::: "memory"); }
            }
        }
        if (n + 1 < ntiles) ATT_STORE(cur ^ 1);
        __syncthreads();
    }
#undef ATT_LOAD
#undef ATT_STORE
#pragma unroll
    for (int qt = 0; qt < 2; ++qt) { float l = lsum[qt]; l += __shfl_xor(l, 16); l += __shfl_xor(l, 32); const float inv = 1.f / l;
        const int t = b * SEQ + 256 * i + 32 * w + 16 * qt + i16; bf16* op = MIX + (size_t)t * DM + h * 128 + 4 * quad;
#pragma unroll
        for (int dt = 0; dt < 8; ++dt) { v2u o; o.x = pk2(O[qt][dt][0] * inv, O[qt][dt][1] * inv); o.y = pk2(O[qt][dt][2] * inv, O[qt][dt][3] * inv); *(v2u*)(op + 16 * dt) = o; } }
}

__device__ __forceinline__ void ssd_out_unit(const Params& P, int layer, int su) {
    const int tid = fresh_tid(), lane = tid & 63, w = tid >> 6, i16 = lane & 15, quad = lane >> 4; const int b = su >> 6, c = (su >> 1) & 31, g = su & 1;
    const int t0 = b * SEQ + c * 128, s0 = c * 128; const int lq = 16 * w + i16; const int t = t0 + lq;
    unsigned char* ws = P.ws; const bf16* PT = (const bf16*)(ws + OFF_PT); const bf16* CC = (const bf16*)(ws + OFF_CC); const bf16* BMCM = (const bf16*)(ws + OFF_BMCM); bf16* MIX = (bf16*)(ws + OFF_MIX);
    const float* DTt = (const float*)(ws + OFF_DT); const float* ACt = (const float*)(ws + OFF_ACUM); const bf16* HIN = (const bf16*)(ws + OFF_HIN);
    const float* dskip = P.in[9] + layer * 16; const float* nw = P.in[10] + layer * 1024;
    bf16x8 Bcm[4];
#pragma unroll
    for (int ns = 0; ns < 4; ++ns) Bcm[ns] = *(const bf16x8*)(BMCM + (size_t)t * 512 + 256 + 128 * g + 32 * ns + 8 * quad);
    const int nss = (w >> 1) + 1;
    f32x4 CBa[4], CBb[4];
#pragma unroll
    for (int ss = 0; ss < 4; ++ss) { CBa[ss] = (f32x4){0.f, 0.f, 0.f, 0.f}; CBb[ss] = (f32x4){0.f, 0.f, 0.f, 0.f};
        if (ss < nss) { const int sa = 32 * ss + 8 * (i16 >> 2) + (i16 & 3);
#pragma unroll
            for (int ns = 0; ns < 4; ++ns) { const bf16x8 Aa = *(const bf16x8*)(BMCM + (size_t)(t0 + sa) * 512 + 128 * g + 32 * ns + 8 * quad), Ab = *(const bf16x8*)(BMCM + (size_t)(t0 + sa + 4) * 512 + 128 * g + 32 * ns + 8 * quad);
                CBa[ss] = MFMA16(Aa, Bcm[ns], CBa[ss]); CBb[ss] = MFMA16(Ab, Bcm[ns], CBb[ss]); } } }
    float ssq = 0.f;
#pragma unroll 1
    for (int r = 0; r < 8; ++r) { const int hd = 8 * g + r; const size_t hoff = (size_t)(b * 16 + hd) * SEQ + s0;
        const float al = ACt[hoff + lq]; const float el = __expf(al);
        f32x4 yd[4], yo[4];
#pragma unroll
        for (int pt = 0; pt < 4; ++pt) { yd[pt] = (f32x4){0.f, 0.f, 0.f, 0.f}; yo[pt] = (f32x4){0.f, 0.f, 0.f, 0.f}; }
#pragma unroll
        for (int ss = 0; ss < 4; ++ss) { if (ss < nss) { const int sb = 32 * ss + 8 * quad;
                const f32x4 a0 = *(const f32x4*)(ACt + hoff + sb), a1 = *(const f32x4*)(ACt + hoff + sb + 4), d0 = *(const f32x4*)(DTt + hoff + sb), d1 = *(const f32x4*)(DTt + hoff + sb + 4);
                float m[8];
#pragma unroll
                for (int e = 0; e < 4; ++e) { m[e] = (sb + e <= lq) ? CBa[ss][e] * __expf(al - a0[e]) * d0[e] : 0.f; m[4 + e] = (sb + 4 + e <= lq) ? CBb[ss][e] * __expf(al - a1[e]) * d1[e] : 0.f; }
                v4u pk; pk.x = pk2(m[0], m[1]); pk.y = pk2(m[2], m[3]); pk.z = pk2(m[4], m[5]); pk.w = pk2(m[6], m[7]); const bf16x8 Bm = __builtin_bit_cast(bf16x8, pk);
#pragma unroll
                for (int pt = 0; pt < 4; ++pt) { const bf16x8 Ax = *(const bf16x8*)(CC + (size_t)(512 * g + 64 * r + 16 * pt + i16) * T + t0 + sb); yd[pt] = MFMA16(Ax, Bm, yd[pt]); } } }
        const bf16* hp = HIN + (size_t)((b * 32 + c) * 16 + hd) * 8192;
#pragma unroll
        for (int pt = 0; pt < 4; ++pt)
#pragma unroll
            for (int ns = 0; ns < 4; ++ns) { const bf16x8 Ah = *(const bf16x8*)(hp + (16 * pt + i16) * 128 + 32 * ns + 8 * quad); yo[pt] = MFMA16(Ah, Bcm[ns], yo[pt]); }
        const float dsk = dskip[hd];
#pragma unroll
        for (int pt = 0; pt < 4; ++pt) { const int p0 = 16 * pt + 4 * quad; const int chn = 512 * g + 64 * r + p0;
            const v2u zr = *(const v2u*)(PT + (size_t)t * NPT + PT_Z + chn); const float z[4] = {bflo(zr.x), bfhi(zr.x), bflo(zr.y), bfhi(zr.y)}; float v[4];
#pragma unroll
            for (int e = 0; e < 4; ++e) { const float xs = bf1(CC[(size_t)(chn + e) * T + t]); const float y = yd[pt][e] + yo[pt][e] * el + dsk * xs; v[e] = y * silu_f(z[e]); ssq += v[e] * v[e]; }
            v2u o; o.x = pk2(v[0], v[1]); o.y = pk2(v[2], v[3]); *(v2u*)(MIX + (size_t)t * DM + 1024 + chn) = o; } }
    ssq += __shfl_xor(ssq, 16); ssq += __shfl_xor(ssq, 32);
    const float rs = __builtin_amdgcn_rsqf(ssq * (1.f / 512.f) + EPS);
#pragma unroll 1
    for (int r = 0; r < 8; ++r)
#pragma unroll
        for (int pt = 0; pt < 4; ++pt) { const int chn = 512 * g + 64 * r + 16 * pt + 4 * quad; bf16* mp = MIX + (size_t)t * DM + 1024 + chn;
            const v2u vr = *(const v2u*)mp; const f32x4 wv = *(const f32x4*)(nw + chn);
            v2u o; o.x = pk2(bflo(vr.x) * rs * wv[0], bfhi(vr.x) * rs * wv[1]); o.y = pk2(bflo(vr.y) * rs * wv[2], bfhi(vr.y) * rs * wv[3]); *(v2u*)mp = o; }
}

__device__ __forceinline__ void ffn_conv_phase(const Params& P, int layer) {
    const bf16* U = (const bf16*)(P.ws + OFF_U); bf16* G = (bf16*)(P.ws + OFF_G);
    const float* cw = P.in[14] + (size_t)layer * 3 * NUP; const float* cb = P.in[15] + (size_t)layer * NUP;
    const int gt = fresh_bid() * 512 + fresh_tid(), NT = gridDim.x * 512;
    constexpr int NFG = DFF / 8, RUN = 32, NITEM = (T / RUN) * NFG;
    for (int item = gt; item < NITEM; item += NT) { const int tr = item / NFG, fg = item - tr * NFG; const int f0 = 8 * fg; const int tb = tr * RUN; const int sb = tb & (SEQ - 1);
        float wg[3][8], wv[3][8], bg[8], bv[8];
#pragma unroll
        for (int k = 0; k < 3; ++k) { const f32x4 a = *(const f32x4*)(cw + (size_t)k * NUP + f0), a2 = *(const f32x4*)(cw + (size_t)k * NUP + f0 + 4), c = *(const f32x4*)(cw + (size_t)k * NUP + DFF + f0), c2 = *(const f32x4*)(cw + (size_t)k * NUP + DFF + f0 + 4);
#pragma unroll
            for (int e = 0; e < 4; ++e) { wg[k][e] = a[e]; wg[k][4 + e] = a2[e]; wv[k][e] = c[e]; wv[k][4 + e] = c2[e]; } }
        { const f32x4 a = *(const f32x4*)(cb + f0), a2 = *(const f32x4*)(cb + f0 + 4), c = *(const f32x4*)(cb + DFF + f0), c2 = *(const f32x4*)(cb + DFF + f0 + 4);
#pragma unroll
          for (int e = 0; e < 4; ++e) { bg[e] = a[e]; bg[4 + e] = a2[e]; bv[e] = c[e]; bv[4 + e] = c2[e]; } }
        float g1[8], g2[8], v1[8], v2[8];
#define HALO_ROW(k, dg, dv) do { v4u rg_ = (v4u){0u, 0u, 0u, 0u}, rv_ = (v4u){0u, 0u, 0u, 0u}; \
            if (sb - (k) >= 0) { rg_ = *(const v4u*)(U + (size_t)(tb - (k)) * NUP + f0); rv_ = *(const v4u*)(U + (size_t)(tb - (k)) * NUP + DFF + f0); } \
            _Pragma("unroll") for (int e = 0; e < 4; ++e) { dg[2 * e] = bflo(rg_[e]); dg[2 * e + 1] = bfhi(rg_[e]); dv[2 * e] = bflo(rv_[e]); dv[2 * e + 1] = bfhi(rv_[e]); } } while (0)
        HALO_ROW(1, g1, v1); HALO_ROW(2, g2, v2);
#undef HALO_ROW
#pragma unroll 4
        for (int i = 0; i < RUN; ++i) { const v4u rg = *(const v4u*)(U + (size_t)(tb + i) * NUP + f0), rv = *(const v4u*)(U + (size_t)(tb + i) * NUP + DFF + f0); float g0[8], v0[8], o[8];
#pragma unroll
            for (int e = 0; e < 4; ++e) { g0[2 * e] = bflo(rg[e]); g0[2 * e + 1] = bfhi(rg[e]); v0[2 * e] = bflo(rv[e]); v0[2 * e + 1] = bfhi(rv[e]); }
#pragma unroll
            for (int e = 0; e < 8; ++e) { const float ug = bg[e] + wg[0][e] * g2[e] + wg[1][e] * g1[e] + wg[2][e] * g0[e]; const float uv = bv[e] + wv[0][e] * v2[e] + wv[1][e] * v1[e] + wv[2][e] * v0[e];
                o[e] = silu_f(ug) * uv; g2[e] = g1[e]; g1[e] = g0[e]; v2[e] = v1[e]; v1[e] = v0[e]; }
            v4u ov; ov.x = pk2(o[0], o[1]); ov.y = pk2(o[2], o[3]); ov.z = pk2(o[4], o[5]); ov.w = pk2(o[6], o[7]);
            *(v4u*)(G + (size_t)(tb + i) * DFF + f0) = ov; } }
}

__global__ void __launch_bounds__(512, 2) hymba_fwd(Params P) {
    extern __shared__ __attribute__((aligned(16))) unsigned char lds[];
    cg::grid_group grid = cg::this_grid();
    const int G = gridDim.x, bx = blockIdx.x;
    unsigned char* ws = P.ws;
    LAS unsigned char* llds = (LAS unsigned char*)lds;
    PG8_LAS unsigned char* glds = (PG8_LAS unsigned char*)lds;
    bf16* XB = (bf16*)(ws + OFF_XB); float* SS = (float*)(ws + OFF_SS);

    phase_x0(P);
    convert_jobs(P, 0, 0, 8, llds);
    grid.sync();
#pragma unroll 1
    for (int L = 0; L < 2; ++L) {
        { pg8::Gemm g{XB, (const bf16*)(ws + OFF_WB), (const bf16*)(ws + OFF_WA), XB, DM};
          pg8::DualOrder S{T / 256, NPT / 256, NCT / 256, T / 256, G, bx};
          pg8::EpiScale E{(bf16*)(ws + OFF_PT), NPT, (bf16*)(ws + OFF_CT), T, SS + (2 * L) * T, 1.f / DM};
          pg8::gemm_phase<pg8::EpiScale, pg8::DualOrder, true, true>(glds, g, S, E); }
        grid.sync();
#ifndef NO_PREP
        for (int dd = 0; dd < DUP_MISC; ++dd) for (int u = bx; u < 256; u += G) ssd_prep_unit(P, L, u, llds);
#endif
#ifndef NO_KNORM
        for (int u = bx; u < 512; u += G) knorm_unit(P, L, u, llds);
#endif
        if (L == 1) convert_jobs(P, 1, 7, 8, llds);
        grid.sync();
        for (int dd = 0; dd < DUP_MISC; ++dd) scan_phase(P);
#ifndef NO_ATTN
        for (int u = bx; u < 256; u += G) { const int bh = u >> 3, pi = u & 7;
#pragma unroll 1
            for (int rep = 0; rep < 2 * DUP_ATTN; ++rep) attn_unit(P, L, bh >> 3, bh & 7, (rep & 1) ? pi : 15 - pi, llds); }
#endif
        grid.sync();
#ifndef NO_SSDOUT
        for (int dd = 0; dd < DUP_MISC; ++dd) for (int u = bx; u < 256; u += G) ssd_out_unit(P, L, u);
#endif
        grid.sync();
        { pg8::Gemm g{(const bf16*)(ws + OFF_MIX), nullptr, (const bf16*)(ws + OFF_WOUT), nullptr, DM};
          pg8::DualOrder S{T / 256, DM / 256, 0, 0, G, bx};
          pg8::EpiResid E{L == 0 ? P.in[0] : P.out, P.out, XB, SS + (2 * L + 1) * T};
          pg8::gemm_phase<pg8::EpiResid, pg8::DualOrder, true, true>(glds, g, S, E); }
        grid.sync();
        { pg8::Gemm g{XB, nullptr, (const bf16*)(ws + OFF_WUP), nullptr, DM};
          pg8::DualOrder S{T / 256, NUP / 256, 0, 0, G, bx};
          pg8::EpiScale E{(bf16*)(ws + OFF_U), NUP, nullptr, 0, SS + (2 * L + 1) * T, 1.f / DM};
          pg8::gemm_phase<pg8::EpiScale, pg8::DualOrder, true, true>(glds, g, S, E);
#ifdef DUP_UP
          pg8::gemm_phase<pg8::EpiScale, pg8::DualOrder, true, true>(glds, g, S, E);
#endif
        }
        grid.sync();
#ifndef NO_FFNCONV
        for (int dd = 0; dd < DUP_MISC; ++dd) ffn_conv_phase(P, L);
#endif
        if (L == 0) convert_jobs(P, 1, 0, 7, llds);
        grid.sync();
        { pg8::Gemm g{(const bf16*)(ws + OFF_G), nullptr, (const bf16*)(ws + OFF_WDOWN), nullptr, DFF};
          pg8::DualOrder S{T / 256, DM / 256, 0, 0, G, bx};
          pg8::EpiResid E{P.out, P.out, XB, L == 0 ? SS + 2 * T : nullptr};
          pg8::gemm_phase<pg8::EpiResid, pg8::DualOrder, true, true>(glds, g, S, E); }
        if (L == 0) grid.sync();
    }
}

extern "C" void kernel_launch(void* const* d_in, const int* in_sizes, int n_in, void* d_out, int out_size, void* d_ws, size_t ws_size, hipStream_t stream) {
    static int grid = 0;
    if (grid == 0) {
        if (n_in != 17 || in_sizes[0] != T * DM || out_size != T * DM || ws_size < WS_NEED) { fprintf(stderr, "kernel_launch: unexpected shapes / workspace (n_in %d, ws %zu, need %zu)\n", n_in, ws_size, (size_t)WS_NEED); grid = -1; return; }
        int dev = 0, cus = 0, per_cu = 0;
        hipGetDevice(&dev); hipDeviceGetAttribute(&cus, hipDeviceAttributeMultiprocessorCount, dev);
        if (hipFuncSetAttribute((const void*)hymba_fwd, hipFuncAttributeMaxDynamicSharedMemorySize, LDS_BYTES) != hipSuccess) { fprintf(stderr, "kernel_launch: hipFuncSetAttribute failed\n"); grid = -1; return; }
        if (hipOccupancyMaxActiveBlocksPerMultiprocessor(&per_cu, (const void*)hymba_fwd, 512, LDS_BYTES) != hipSuccess || per_cu < 1) { fprintf(stderr, "kernel_launch: occupancy query gave %d\n", per_cu); per_cu = 1; }
        (void)hipGetLastError();
        grid = cus * 1;
        if (grid <= 0) grid = 256;
    }
    if (grid < 0) return;
    Params p{};
    for (int i = 0; i < 17; ++i) p.in[i] = (const float*)d_in[i];
    p.out = (float*)d_out; p.ws = (unsigned char*)d_ws;
    void* args[] = {&p};
    hipError_t e = hipLaunchCooperativeKernel((const void*)hymba_fwd, dim3(grid), dim3(512), args, LDS_BYTES, stream);
    if (e != hipSuccess) fprintf(stderr, "cooperative launch failed: %s (grid %d)\n", hipGetErrorString(e), grid);
}
```

```cpp
#include <hip/hip_runtime.h>
#include <hip/hip_cooperative_groups.h>
#include <cstdio>
#include <cstdint>
namespace cg = cooperative_groups;
#ifdef DUP_SYNC
#define GSYNC() do { xcd_barrier(xbar); xcd_barrier(xbar); } while (0)
#else
#define GSYNC() xcd_barrier(xbar)
#endif
#ifndef DUP_CONV
#define DUP_CONV 1
#endif
#ifndef DUP_ATTN
#define DUP_ATTN 1
#endif
#ifndef DUP_MISC
#define DUP_MISC 1
#endif

namespace pg8 {
#define PG8_LAS __attribute__((address_space(3)))
typedef unsigned short bf16_t;
typedef short bf16x8 __attribute__((ext_vector_type(8)));
typedef float f32x4 __attribute__((ext_vector_type(4)));
typedef unsigned u32x4 __attribute__((ext_vector_type(4)));
constexpr int BM = 256, BK = 64, HALF = 128, HTB = HALF * BK * 2  , STAGE_BYTES = 8 * HTB, NXCD = 8, WGM = 8;

__host__ __device__ __forceinline__ int lds_byte(int r, int c) { const int st = (r >> 4) * 2 + (c >> 5), rr = r & 15, cc = c & 31, ob = rr * 64 + cc * 2; return st * 1024 + (ob ^ (((ob >> 9) & 1) << 5)); }
__host__ __device__ __forceinline__ void stage_rc(int b, int& R, int& C) { const int st = b / 1024, sb = b % 1024, swz = sb ^ (((sb >> 9) & 1) << 5); R = (st >> 1) * 16 + swz / 64; C = (st & 1) * 32 + (swz % 64) / 2; }
__host__ __device__ __forceinline__ int perm32(int rho) { const int n = rho >> 4, i = rho & 15; return 8 * (i >> 2) + 4 * n + (i & 3); }

struct Unit { int pm, pn, kind; };
struct Gemm { const bf16_t *A0, *A1, *B0, *B1; int K; };

__device__ __forceinline__ void tile_map(int L, int nM, int nN, int& pm, int& pn) {
    const int nwg = nM * nN; int wgid = L;
    { const int q = nwg / NXCD, r = nwg % NXCD, xcd = wgid % NXCD, off = wgid / NXCD; wgid = (xcd < r ? xcd * (q + 1) : r * (q + 1) + (xcd - r) * q) + off; }
    const int nig = WGM * nN, gid = wgid / nig, fm = gid * WGM, gsz = (nM - fm) < WGM ? (nM - fm) : WGM;
    pm = fm + ((wgid % nig) % gsz); pn = (wgid % nig) / gsz;
}
struct DualOrder {
    int nM0, nN0, nM1, nN1, G, c;
    __device__ __forceinline__ bool next(int i, Unit& u) const {
        const int L = i * G + c; const int n0 = nM0 * nN0, n1 = nM1 * nN1;
        if (L < n0) { tile_map(L, nM0, nN0, u.pm, u.pn); u.kind = 0; return true; }
        if (L < n0 + n1) { tile_map(L - n0, nM1, nN1, u.pm, u.pn); u.kind = 1; return true; }
        return false;
    }
    __device__ __forceinline__ void a_ready(const Unit&) const {}
    __device__ __forceinline__ void done(const Unit&) const {}
};

__device__ __forceinline__ unsigned cvt_pk_bf16(float lo, float hi) { unsigned r; asm volatile("v_cvt_pk_bf16_f32 %0, %1, %2" : "=v"(r) : "v"(lo), "v"(hi)); return r; }

constexpr float RMS_EPS = 1e-6f;
struct EpiScale {
    static constexpr bool PERM = true, AFTER_DRAIN = false;
    bf16_t* O0; int ld0; bf16_t* O1; int ld1; const float* ss; float invn;
    __device__ __forceinline__ void operator()(const f32x4 (&acc)[2][2][4][2], const Unit& u, int wr, int wc, int fr, int fq) const {
        const int row0 = u.pm * BM + wr * 64 + fr, col0 = u.pn * BM + wc * 32 + 8 * fq;
        if (u.kind == 0) {
#pragma unroll
            for (int ai = 0; ai < 2; ++ai)
#pragma unroll
                for (int m = 0; m < 4; ++m) { const int r = row0 + ai * HALF + m * 16; const float rs = __builtin_amdgcn_rsqf(ss[r] * invn + RMS_EPS);
                    bf16_t* rowp = O0 + (size_t)r * ld0 + col0;
#pragma unroll
                    for (int bj = 0; bj < 2; ++bj) { const f32x4 v0 = acc[ai][bj][m][0] * rs, v1 = acc[ai][bj][m][1] * rs;
                        u32x4 w; w.x = cvt_pk_bf16(v0[0], v0[1]); w.y = cvt_pk_bf16(v0[2], v0[3]); w.z = cvt_pk_bf16(v1[0], v1[1]); w.w = cvt_pk_bf16(v1[2], v1[3]);
                        *(u32x4*)(rowp + bj * HALF) = w; } }
        } else {
            f32x4 rsv[2][2];
#pragma unroll
            for (int bj = 0; bj < 2; ++bj)
#pragma unroll
                for (int n = 0; n < 2; ++n) { const f32x4 s4 = *(const f32x4*)(ss + col0 + bj * HALF + 4 * n);
#pragma unroll
                    for (int e = 0; e < 4; ++e) rsv[bj][n][e] = __builtin_amdgcn_rsqf(s4[e] * invn + RMS_EPS); }
#pragma unroll
            for (int ai = 0; ai < 2; ++ai)
#pragma unroll
                for (int m = 0; m < 4; ++m) { const int r = row0 + ai * HALF + m * 16; bf16_t* rowp = O1 + (size_t)r * ld1 + col0;
#pragma unroll
                    for (int bj = 0; bj < 2; ++bj) { const f32x4 v0 = acc[ai][bj][m][0] * rsv[bj][0], v1 = acc[ai][bj][m][1] * rsv[bj][1];
                        u32x4 w; w.x = cvt_pk_bf16(v0[0], v0[1]); w.y = cvt_pk_bf16(v0[2], v0[3]); w.z = cvt_pk_bf16(v1[0], v1[1]); w.w = cvt_pk_bf16(v1[2], v1[3]);
                        *(u32x4*)(rowp + bj * HALF) = w; } }
        }
    }
};
struct EpiResid {
    static constexpr bool PERM = true, AFTER_DRAIN = false;
    const float* xold; float* xnew; bf16_t* xb; float* ssout;
    __device__ __forceinline__ void operator()(const f32x4 (&acc)[2][2][4][2], const Unit& u, int wr, int wc, int fr, int fq) const {
        const int row0 = u.pm * BM + wr * 64 + fr, col0 = u.pn * BM + wc * 32 + 8 * fq;
#pragma unroll
        for (int ai = 0; ai < 2; ++ai)
#pragma unroll
            for (int m = 0; m < 4; ++m) { const int r = row0 + ai * HALF + m * 16; const size_t off = (size_t)r * 2048 + col0; float part = 0.f;
#pragma unroll
                for (int bj = 0; bj < 2; ++bj) { const f32x4 o0 = *(const f32x4*)(xold + off + bj * HALF), o1 = *(const f32x4*)(xold + off + bj * HALF + 4);
                    const f32x4 v0 = o0 + acc[ai][bj][m][0], v1 = o1 + acc[ai][bj][m][1];
                    *(f32x4*)(xnew + off + bj * HALF) = v0; *(f32x4*)(xnew + off + bj * HALF + 4) = v1;
                    u32x4 w; w.x = cvt_pk_bf16(v0[0], v0[1]); w.y = cvt_pk_bf16(v0[2], v0[3]); w.z = cvt_pk_bf16(v1[0], v1[1]); w.w = cvt_pk_bf16(v1[2], v1[3]);
                    *(u32x4*)(xb + off + bj * HALF) = w;
                    part += (v0[0] * v0[0] + v0[1] * v0[1]) + (v0[2] * v0[2] + v0[3] * v0[3]) + (v1[0] * v1[0] + v1[1] * v1[1]) + (v1[2] * v1[2] + v1[3] * v1[3]); }
                part += __shfl_xor(part, 16); part += __shfl_xor(part, 32);
                if (ssout != nullptr && fq == 0) atomicAdd(ssout + r, part); }
    }
};

template <class Epi, class Sched, bool ALIGN_EPI = false, bool SP2 = false>
__device__ __forceinline__ void gemm_phase(PG8_LAS unsigned char* lds, const Gemm g, const Sched& S, const Epi& E) {
    int tid = threadIdx.x; asm volatile("" : "+v"(tid)); const int wid = __builtin_amdgcn_readfirstlane(tid >> 6), lane = tid & 63, wr = wid >> 2, wc = wid & 3, fr = lane & 15, fq = lane >> 4;
    int K = g.K; asm volatile("" : "+s"(K)); const int nt = K / BK;
    unsigned voffA[2], voffB[2];
#pragma unroll
    for (int i = 0; i < 2; ++i) { int R, C; stage_rc(tid * 16 + i * 8192, R, C); const int Rb = Epi::PERM ? ((R & ~31) + perm32(R & 31)) : R;
        voffA[i] = (unsigned)(R * K + C) * 2u; voffB[i] = (unsigned)(Rb * K + C) * 2u; }
    const size_t kstep = (size_t)(BK * 2);
    const size_t hstep = (size_t)HALF * K * 2;
    const size_t tstep = 2 * hstep;
    const unsigned ldsw = (unsigned)wid * 1024u;
    const int aoff = lds_byte(wr * 64 + fr, fq * 8), boff = lds_byte(wc * 32 + fr, fq * 8);
#define PG8_SA(b, h) (((b) * 2 + (h)) * HTB)
#define PG8_SB(b, h) ((4 + (b) * 2 + (h)) * HTB)
#define PG8_STAGE(bufoff, gbase, voff) do { _Pragma("unroll") for (int _i = 0; _i < 2; ++_i) \
        __builtin_amdgcn_global_load_lds((const unsigned*)((const char*)(gbase) + (voff)[_i]), (PG8_LAS unsigned*)(lds + (bufoff) + ldsw + _i * 8192), 16, 0, 0); } while (0)
#define PG8_LDA(dst, b, h) do { _Pragma("unroll") for (int m = 0; m < 4; ++m) _Pragma("unroll") for (int k = 0; k < 2; ++k) dst[m][k] = *(const PG8_LAS bf16x8*)(lds + PG8_SA(b, h) + aoff + m * 2048 + k * 1024); } while (0)
#define PG8_LDB(dst, b, h) do { _Pragma("unroll") for (int n = 0; n < 2; ++n) _Pragma("unroll") for (int k = 0; k < 2; ++k) dst[n][k] = *(const PG8_LAS bf16x8*)(lds + PG8_SB(b, h) + boff + n * 2048 + k * 1024); } while (0)
#define PG8_MMA(ai, bj, At, Bt) do { __builtin_amdgcn_s_setprio(1); _Pragma("unroll") for (int m = 0; m < 4; ++m) _Pragma("unroll") for (int n = 0; n < 2; ++n) _Pragma("unroll") for (int k = 0; k < 2; ++k) \
        acc[ai][bj][m][n] = __builtin_amdgcn_mfma_f32_16x16x32_bf16(Bt[n][k], At[m][k], acc[ai][bj][m][n], 0, 0, 0); __builtin_amdgcn_s_setprio(0); } while (0)
#define PG8_WAIT_V(n) asm volatile("s_waitcnt vmcnt(" #n ")" ::: "memory")
#define PG8_WAIT_L(n) asm volatile("s_waitcnt lgkmcnt(" #n ")" ::: "memory")
#define PG8_BAR __builtin_amdgcn_s_barrier()
#define PG8_SCHED __builtin_amdgcn_sched_barrier(0)
    Unit cur, nxt; int ui = 0;
    if (!S.next(0, cur)) return;
    f32x4 acc[2][2][4][2];
#pragma unroll
    for (int a = 0; a < 2; ++a)
#pragma unroll
        for (int b = 0; b < 2; ++b)
#pragma unroll
            for (int m = 0; m < 4; ++m)
#pragma unroll
                for (int n = 0; n < 2; ++n) acc[a][b][m][n] = (f32x4){0.f, 0.f, 0.f, 0.f};
    bf16x8 At[4][2], B0[2][2], B1[2][2];
    const char* cA = (const char*)(cur.kind ? g.A1 : g.A0) + (size_t)cur.pm * tstep; const char* cB = (const char*)(cur.kind ? g.B1 : g.B0) + (size_t)cur.pn * tstep;
    S.a_ready(cur);
    if constexpr (SP2) {
        PG8_STAGE(PG8_SB(0, 0), cB, voffB); PG8_STAGE(PG8_SB(0, 1), cB + hstep, voffB); PG8_STAGE(PG8_SA(0, 0), cA, voffA); PG8_STAGE(PG8_SA(0, 1), cA + hstep, voffA);
        if (wr == 1) PG8_BAR;
        PG8_WAIT_V(2); PG8_BAR;
        PG8_STAGE(PG8_SB(1, 0), cB + kstep, voffB); PG8_STAGE(PG8_SA(1, 0), cA + kstep, voffA); PG8_STAGE(PG8_SB(1, 1), cB + hstep + kstep, voffB);
        PG8_WAIT_V(6); PG8_BAR;
    } else {
        PG8_STAGE(PG8_SB(0, 0), cB, voffB); PG8_STAGE(PG8_SA(0, 0), cA, voffA); PG8_STAGE(PG8_SB(0, 1), cB + hstep, voffB); PG8_STAGE(PG8_SA(0, 1), cA + hstep, voffA);
        if (wr == 1) PG8_BAR;
        PG8_WAIT_V(4); PG8_BAR;
        PG8_STAGE(PG8_SB(1, 0), cB + kstep, voffB); PG8_STAGE(PG8_SA(1, 0), cA + kstep, voffA); PG8_STAGE(PG8_SB(1, 1), cB + hstep + kstep, voffB);
        PG8_WAIT_V(6); PG8_BAR;
    }
    for (;;) {
        const bool has_next = S.next(ui + 1, nxt);
        const char* nA = has_next ? (const char*)(nxt.kind ? g.A1 : g.A0) + (size_t)nxt.pm * tstep : cA; const char* nB = has_next ? (const char*)(nxt.kind ? g.B1 : g.B0) + (size_t)nxt.pn * tstep : cB;
        for (int t = 0; t < nt; t += 2) {
            const bool last = (t == nt - 2);
            const char* a1 = cA + (size_t)(t + 1) * kstep;
            const char* a2 = last ? nA : cA + (size_t)(t + 2) * kstep; const char* b2 = last ? nB : cB + (size_t)(t + 2) * kstep;
            const char* a3 = a2 + kstep; const char* b3 = b2 + kstep;
            if (last && has_next) S.a_ready(nxt);
            if constexpr (SP2) {
            PG8_LDB(B0, 0, 0); PG8_LDB(B1, 0, 1); PG8_SCHED; PG8_LDA(At, 0, 0); PG8_STAGE(PG8_SA(1, 1), a1 + hstep, voffA);
            PG8_WAIT_V(8); PG8_WAIT_L(0); PG8_BAR; PG8_MMA(0, 0, At, B0); PG8_MMA(0, 1, At, B1); PG8_BAR; PG8_SCHED;
            PG8_LDA(At, 0, 1); PG8_STAGE(PG8_SB(0, 0), b2, voffB); PG8_STAGE(PG8_SB(0, 1), b2 + hstep, voffB); PG8_STAGE(PG8_SA(0, 0), a2, voffA);
            PG8_WAIT_V(8); PG8_WAIT_L(0); PG8_BAR; PG8_MMA(1, 0, At, B0); PG8_MMA(1, 1, At, B1); PG8_BAR; PG8_SCHED;
            PG8_LDB(B0, 1, 0); PG8_LDB(B1, 1, 1); PG8_SCHED; PG8_LDA(At, 1, 0); PG8_STAGE(PG8_SA(0, 1), a2 + hstep, voffA);
            PG8_WAIT_V(8); PG8_WAIT_L(0); PG8_BAR; PG8_MMA(0, 0, At, B0); PG8_MMA(0, 1, At, B1); PG8_BAR; PG8_SCHED;
            PG8_LDA(At, 1, 1); PG8_STAGE(PG8_SB(1, 0), b3, voffB); PG8_STAGE(PG8_SB(1, 1), b3 + hstep, voffB); PG8_STAGE(PG8_SA(1, 0), a3, voffA);
            PG8_WAIT_V(8); PG8_WAIT_L(0); PG8_BAR; PG8_MMA(1, 0, At, B0); PG8_MMA(1, 1, At, B1); PG8_BAR; PG8_SCHED;
            } else {
            PG8_LDB(B0, 0, 0); PG8_SCHED; PG8_LDA(At, 0, 0); PG8_STAGE(PG8_SA(1, 1), a1 + hstep, voffA);
            PG8_WAIT_L(8); PG8_BAR; PG8_WAIT_L(0); PG8_MMA(0, 0, At, B0); PG8_BAR; PG8_SCHED;
            PG8_LDB(B1, 0, 1); PG8_STAGE(PG8_SB(0, 0), b2, voffB);
            PG8_BAR; PG8_WAIT_L(0); PG8_MMA(0, 1, At, B1); PG8_BAR;
            PG8_LDA(At, 0, 1); PG8_STAGE(PG8_SA(0, 0), a2, voffA);
            PG8_BAR; PG8_WAIT_L(0); PG8_MMA(1, 0, At, B0); PG8_BAR; PG8_SCHED;
            PG8_STAGE(PG8_SB(0, 1), b2 + hstep, voffB);
            PG8_WAIT_V(6); PG8_BAR; PG8_MMA(1, 1, At, B1); PG8_BAR;
            PG8_LDB(B0, 1, 0); PG8_SCHED; PG8_LDA(At, 1, 0); PG8_STAGE(PG8_SA(0, 1), a2 + hstep, voffA);
            PG8_WAIT_L(8); PG8_BAR; PG8_WAIT_L(0); PG8_MMA(0, 0, At, B0); PG8_BAR; PG8_SCHED;
            PG8_LDB(B1, 1, 1); PG8_STAGE(PG8_SB(1, 0), b3, voffB);
            PG8_BAR; PG8_WAIT_L(0); PG8_MMA(0, 1, At, B1); PG8_BAR;
            PG8_LDA(At, 1, 1); PG8_STAGE(PG8_SA(1, 0), a3, voffA);
            PG8_BAR; PG8_WAIT_L(0); PG8_MMA(1, 0, At, B0); PG8_BAR; PG8_SCHED;
            PG8_STAGE(PG8_SB(1, 1), b3 + hstep, voffB);
            PG8_WAIT_V(6); PG8_BAR; PG8_MMA(1, 1, At, B1); PG8_BAR;
            }
        }
        if constexpr (ALIGN_EPI) { if (wr == 0) PG8_BAR; }
        if constexpr (!Epi::AFTER_DRAIN) { E(acc, cur, wr, wc, fr, fq); S.done(cur); }
        if (!has_next) break;
#pragma unroll
        for (int a = 0; a < 2; ++a)
#pragma unroll
            for (int b = 0; b < 2; ++b)
#pragma unroll
                for (int m = 0; m < 4; ++m)
#pragma unroll
                    for (int n = 0; n < 2; ++n) acc[a][b][m][n] = (f32x4){0.f, 0.f, 0.f, 0.f};
        cur = nxt; cA = nA; cB = nB; ++ui;
        if constexpr (ALIGN_EPI) { if (wr == 1) PG8_BAR; }
    }
    PG8_WAIT_V(0);
    if constexpr (!ALIGN_EPI) { if (wr == 0) PG8_BAR; }
    PG8_BAR;
    if constexpr (Epi::AFTER_DRAIN) { E.fused(acc, cur, wr, wc, fr, fq, lds, wid, lane); S.done(cur); }
#undef PG8_SA
#undef PG8_SB
#undef PG8_STAGE
#undef PG8_LDA
#undef PG8_LDB
#undef PG8_MMA
#undef PG8_WAIT_V
#undef PG8_WAIT_L
#undef PG8_BAR
#undef PG8_SCHED
}
}

#define LAS __attribute__((address_space(3)))
typedef unsigned short bf16;
typedef unsigned v4u __attribute__((ext_vector_type(4)));
typedef unsigned v2u __attribute__((ext_vector_type(2)));
typedef float f32x4 __attribute__((ext_vector_type(4)));
typedef float f32x2 __attribute__((ext_vector_type(2)));
typedef short bf16x8 __attribute__((ext_vector_type(8)));

constexpr int T = 16384, SEQ = 4096, DM = 2048, NPT = 3840, NCT = 2304, NCC = 1280, DFF = 5632, NUP = 11264, INC = 5648;
constexpr float EPS = 1e-6f;
constexpr int PT_Q = 0, PT_K = 1024, PT_Z = 2048, PT_BM = 3072, PT_CM = 3328, PT_DT = 3584;
constexpr size_t SZ_WA = (size_t)NPT * DM * 2, SZ_WB = (size_t)NCT * DM * 2, SZ_WOUT = (size_t)DM * DM * 2, SZ_WUP = (size_t)NUP * DM * 2, SZ_WDOWN = (size_t)DM * DFF * 2;
constexpr size_t OFF_WA = 0, OFF_WB = OFF_WA + SZ_WA, OFF_WOUT = OFF_WB + SZ_WB, OFF_WUP = OFF_WOUT + SZ_WOUT, OFF_WDOWN = OFF_WUP + SZ_WUP;
constexpr size_t OFF_XB = OFF_WDOWN + SZ_WDOWN;
constexpr size_t OFF_SMALL = OFF_XB + (size_t)T * DM * 2;
constexpr size_t OFF_DT = OFF_SMALL, OFF_ACUM = OFF_DT + (1u << 20), OFF_CDEC = OFF_ACUM + (1u << 20), OFF_KMEAN = OFF_CDEC + 65536, OFF_SS = OFF_KMEAN + 262144, OFF_CTL = OFF_SS + 4 * 65536;
constexpr size_t OFF_BIG = OFF_SMALL + (4u << 20);
constexpr size_t OFF_PT = OFF_BIG, OFF_CT = OFF_PT + (size_t)T * NPT * 2, OFF_CC = OFF_CT + (size_t)NCT * T * 2, OFF_BMCM = OFF_CC + (size_t)NCC * T * 2;
constexpr size_t OFF_MIX = OFF_BMCM + (size_t)T * 512 * 2, OFF_STATES = OFF_MIX + (size_t)T * DM * 2, OFF_HIN = OFF_STATES + (size_t)2048 * 8192 * 4, OFF_END1 = OFF_HIN + (size_t)2048 * 8192 * 2;
constexpr size_t OFF_U = OFF_BIG, OFF_G = OFF_U + (size_t)T * NUP * 2, OFF_END2 = OFF_G + (size_t)T * DFF * 2;
constexpr size_t WS_NEED = OFF_END2 > OFF_END1 ? OFF_END2 : OFF_END1;
static_assert(WS_NEED <= 738197504ull, "workspace");
static_assert(OFF_CTL + 16384 <= OFF_BIG, "small region");
constexpr int LDS_BYTES = 147456;

struct Params { const float* in[17]; float* out; unsigned char* ws; };

__device__ __forceinline__ float bflo(unsigned u) { return __uint_as_float(u << 16); }
__device__ __forceinline__ float bfhi(unsigned u) { return __uint_as_float(u & 0xffff0000u); }
__device__ __forceinline__ float bf1(bf16 b) { return __uint_as_float(((unsigned)b) << 16); }
__device__ __forceinline__ unsigned pk2(float lo, float hi) { return pg8::cvt_pk_bf16(lo, hi); }
__device__ __forceinline__ float silu_f(float x) { return x / (1.f + __expf(-x)); }
__device__ __forceinline__ float wave_sum(float v) {
#pragma unroll
    for (int o = 1; o < 64; o <<= 1) v += __shfl_xor(v, o);
    return v;
}
__device__ __forceinline__ float wave_max(float v) {
#pragma unroll
    for (int o = 1; o < 64; o <<= 1) v = fmaxf(v, __shfl_xor(v, o));
    return v;
}
__device__ __forceinline__ int fresh_tid() { int t = threadIdx.x; asm volatile("" : "+v"(t)); return t; }
__device__ __forceinline__ int fresh_bid() { int t = blockIdx.x; asm volatile("" : "+s"(t)); return t; }
#define MFMA16(a, b, c) __builtin_amdgcn_mfma_f32_16x16x32_bf16((a), (b), (c), 0, 0, 0)


#define XB_TMO      128
#define XB_XCNT(j)  (256  + 64 * (j))
#define XB_XSUB(j)  (1280 + 64 * (j))
#define XB_XGEN(j)  (2304 + 64 * (j))
#define XB_TOP      3328
#define XB_TOPGEN   3392
#define XCD_BAR_WORDS 3456
#define XB_SPIN_CAP (1u << 22)
__device__ __forceinline__ unsigned xb_ld(unsigned* p)              { return __hip_atomic_load(p, __ATOMIC_RELAXED, __HIP_MEMORY_SCOPE_AGENT); }
__device__ __forceinline__ unsigned xb_add(unsigned* p, unsigned v) { return __hip_atomic_fetch_add(p, v, __ATOMIC_RELAXED, __HIP_MEMORY_SCOPE_AGENT); }
__device__ __forceinline__ unsigned xb_xcc_id() { return (unsigned)__builtin_amdgcn_s_getreg((3 << 11) | 20) & 0xFu; }
#define XB_SPIN(cond, bar) do { unsigned _sp = 0; while (cond) { __builtin_amdgcn_s_sleep(1); \
    if ((++_sp & 255u) == 0u) { if (xb_ld(&(bar)[XB_TMO])) break; if (_sp > XB_SPIN_CAP) { atomicAdd(&(bar)[XB_TMO], 1u); break; } } } } while (0)
struct XcdBarrier { unsigned* bar; unsigned x; volatile LAS unsigned* st; };
__device__ __forceinline__ XcdBarrier xcd_barrier_post(unsigned* bar, volatile LAS unsigned* st) {
    XcdBarrier b; b.bar = bar; b.x = xb_xcc_id(); b.st = st;
    if (threadIdx.x == 0) (void)xb_add(&bar[XB_XCNT(b.x)], 1u);
    return b;
}
__device__ __forceinline__ void xcd_barrier_complete(unsigned* bar, unsigned x, unsigned& nloc, unsigned& nx) {
    const unsigned G = gridDim.x * gridDim.y * gridDim.z;
    unsigned sum, cnt, mine, sp = 0u;
    for (;;) {
        sum = 0u; cnt = 0u; mine = 0u;
#pragma unroll
        for (unsigned j = 0; j < 16; ++j) { const unsigned c = xb_ld(&bar[XB_XCNT(j)]); sum += c; cnt += (c > 0u) ? 1u : 0u; mine = (j == x) ? c : mine; }
        if (sum == G) break;
        __builtin_amdgcn_s_sleep(1);
        if ((++sp & 255u) == 0u) { if (xb_ld(&bar[XB_TMO])) break; if (sp > XB_SPIN_CAP) { atomicAdd(&bar[XB_TMO], 1u); break; } }
    }
    nloc = mine > 0u ? mine : 1u; nx = cnt > 0u ? cnt : 1u;
}
__device__ __forceinline__ void xcd_barrier(const XcdBarrier& b) {
    asm volatile("s_waitcnt vmcnt(0)" ::: "memory");
    __syncthreads();
    if (threadIdx.x == 0) {
        unsigned* bar = b.bar;
        __builtin_amdgcn_s_waitcnt(0);
        unsigned nloc = b.st[0], nx = b.st[1];
        if (nloc == 0u) { xcd_barrier_complete(bar, b.x, nloc, nx); b.st[0] = nloc; b.st[1] = nx; }
        const unsigned old = xb_add(&bar[XB_XSUB(b.x)], 1u);
        const unsigned gen = old / nloc;
        if (old + 1u == (gen + 1u) * nloc) {
            __builtin_amdgcn_fence(__ATOMIC_RELEASE, "agent");
            asm volatile("s_waitcnt vmcnt(0)" ::: "memory");
            const unsigned og = xb_add(&bar[XB_TOP], 1u);
            const unsigned tg = og / nx;
            if (og + 1u == (tg + 1u) * nx) xb_add(&bar[XB_TOPGEN], 1u);
            else XB_SPIN(xb_ld(&bar[XB_TOPGEN]) == tg, bar);
            __builtin_amdgcn_fence(__ATOMIC_ACQUIRE, "agent");
            xb_add(&bar[XB_XGEN(b.x)], 1u);
            asm volatile("s_waitcnt vmcnt(0)" ::: "memory");
        } else {
            XB_SPIN(xb_ld(&bar[XB_XGEN(b.x)]) == gen, bar);
            __builtin_amdgcn_fence(__ATOMIC_ACQUIRE, "agent");
            asm volatile("s_waitcnt vmcnt(0)" ::: "memory");
        }
    }
    __syncthreads();
}

__device__ __forceinline__ void transpose_item(const float* W, int N, int ncol0, int nvalid, const float* kscale, bf16* WT, int K, int kb, int nb, LAS float* scr, int lane) {
    const int k0 = 64 * kb, n0 = 64 * nb, n4 = (lane & 15) * 4, kr = lane >> 4; const bool ok = (n0 + n4) < nvalid;
    f32x4 v[16];
#pragma unroll
    for (int i = 0; i < 16; ++i) { v[i] = (f32x4){0.f, 0.f, 0.f, 0.f}; if (ok) v[i] = *(const f32x4*)(W + (size_t)(k0 + 4 * i + kr) * N + ncol0 + n0 + n4); }
    if (kscale) {
#pragma unroll
        for (int i = 0; i < 16; ++i) v[i] = v[i] * kscale[k0 + 4 * i + kr]; }
#pragma unroll
    for (int i = 0; i < 16; ++i) { LAS float* d = scr + (4 * i + kr) * 65 + n4; d[0] = v[i][0]; d[1] = v[i][1]; d[2] = v[i][2]; d[3] = v[i][3]; }
    asm volatile("s_waitcnt lgkmcnt(0)" ::: "memory");
    const int c = lane & 7;
#pragma unroll
    for (int jj = 0; jj < 8; ++jj) { const int n = (lane >> 3) + 8 * jj; const LAS float* sp = scr + (8 * c) * 65 + n;
        v4u o; o.x = pk2(sp[0 * 65], sp[1 * 65]); o.y = pk2(sp[2 * 65], sp[3 * 65]); o.z = pk2(sp[4 * 65], sp[5 * 65]); o.w = pk2(sp[6 * 65], sp[7 * 65]);
        *(v4u*)(WT + (size_t)(n0 + n) * K + k0 + 8 * c) = o; }
    asm volatile("s_waitcnt lgkmcnt(0)" ::: "memory");
}
__device__ __forceinline__ void convert_jobs(const Params& P, int layer, int jlo, int jhi, LAS unsigned char* lds) {
    unsigned char* ws = P.ws; const int tid_ = fresh_tid(); const int lane = tid_ & 63, wave_ = __builtin_amdgcn_readfirstlane(tid_ >> 6); const int gw = fresh_bid() * 8 + wave_, NGW = gridDim.x * 8; LAS float* scr = (LAS float*)lds + wave_ * (64 * 65);
    const float* w_in = P.in[2] + (size_t)layer * DM * INC; const float* n1 = P.in[1] + layer * DM; const float* n2 = P.in[12] + layer * DM;
    for (int j = jlo; j < jhi; ++j) {
        const float* W; int N, ncol0, nvalid, nrows, K; const float* ks; bf16* dst;
        if (j == 0)      { W = w_in; N = INC; ncol0 = 0;    nvalid = 2048; nrows = 2048; K = DM; ks = n1; dst = (bf16*)(ws + OFF_WA); }
        else if (j == 1) { W = w_in; N = INC; ncol0 = 3072; nvalid = 1024; nrows = 1024; K = DM; ks = n1; dst = (bf16*)(ws + OFF_WA) + (size_t)2048 * DM; }
        else if (j == 2) { W = w_in; N = INC; ncol0 = 5120; nvalid = 528;  nrows = 768;  K = DM; ks = n1; dst = (bf16*)(ws + OFF_WA) + (size_t)3072 * DM; }
        else if (j == 3) { W = w_in; N = INC; ncol0 = 2048; nvalid = 1024; nrows = 1024; K = DM; ks = n1; dst = (bf16*)(ws + OFF_WB); }
        else if (j == 4) { W = w_in; N = INC; ncol0 = 4096; nvalid = 1280; nrows = 1280; K = DM; ks = n1; dst = (bf16*)(ws + OFF_WB) + (size_t)1024 * DM; }
        else if (j == 5) { W = P.in[11] + (size_t)layer * DM * DM; N = DM; ncol0 = 0; nvalid = DM; nrows = DM; K = DM; ks = nullptr; dst = (bf16*)(ws + OFF_WOUT); }
        else if (j == 6) { W = P.in[13] + (size_t)layer * DM * NUP; N = NUP; ncol0 = 0; nvalid = NUP; nrows = NUP; K = DM; ks = n2; dst = (bf16*)(ws + OFF_WUP); }
        else             { W = P.in[16] + (size_t)layer * DFF * DM; N = DM; ncol0 = 0; nvalid = DM; nrows = DM; K = DFF; ks = nullptr; dst = (bf16*)(ws + OFF_WDOWN); }
        const int nnb = nrows / 64, nitems = (K / 64) * nnb;
        for (int it = gw; it < nitems; it += NGW) transpose_item(W, N, ncol0, nvalid, ks, dst, K, it / nnb, it % nnb, scr, lane);
    }
}

__device__ __forceinline__ void phase_x0(const Params& P) {
    const int tid_ = fresh_tid(); const int lane = tid_ & 63; const int gw = fresh_bid() * 8 + __builtin_amdgcn_readfirstlane(tid_ >> 6), NGW = gridDim.x * 8;
    const float* x = P.in[0]; bf16* xb = (bf16*)(P.ws + OFF_XB); float* ss = (float*)(P.ws + OFF_SS);
    for (int m = gw; m < T; m += NGW) {
        const f32x4* xr = (const f32x4*)(x + (size_t)m * DM) + lane; v2u* o = (v2u*)(xb + (size_t)m * DM) + lane; float s = 0.f;
#pragma unroll
        for (int j = 0; j < 8; ++j) { const f32x4 v = xr[64 * j]; s += (v[0] * v[0] + v[1] * v[1]) + (v[2] * v[2] + v[3] * v[3]); v2u w; w.x = pk2(v[0], v[1]); w.y = pk2(v[2], v[3]); o[64 * j] = w; }
        s = wave_sum(s); if (lane == 0) ss[m] = s;
    }
    const int gt = fresh_bid() * 512 + fresh_tid(), NT = gridDim.x * 512;
    for (int i = gt; i < 3 * T; i += NT) ss[T + i] = 0.f;
}

__device__ __forceinline__ void knorm_unit(const Params& P, int layer, int ku, LAS unsigned char* lds) {
    const int tid = fresh_tid(); const int b = ku >> 7, blk = (ku >> 3) & 15, h = ku & 7;
    bf16* PT = (bf16*)(P.ws + OFF_PT); float* kmean = (float*)(P.ws + OFF_KMEAN); const float* kw = P.in[4] + layer * 128;
    const int row = tid >> 1, half = tid & 1; const int t = b * SEQ + blk * 256 + row;
    bf16* kp = PT + (size_t)t * NPT + PT_K + h * 128 + half * 64;
    v4u raw[8]; float ss = 0.f;
#pragma unroll
    for (int j = 0; j < 8; ++j) { raw[j] = *(const v4u*)(kp + 8 * j);
#pragma unroll
        for (int e = 0; e < 4; ++e) { const float a = bflo(raw[j][e]), c = bfhi(raw[j][e]); ss += a * a + c * c; } }
    ss += __shfl_xor(ss, 1);
    const float rs = __builtin_amdgcn_rsqf(ss * (1.f / 128.f) + EPS);
    LAS bf16* lk = (LAS bf16*)lds;
#pragma unroll
    for (int j = 0; j < 8; ++j) { const f32x4 w0 = *(const f32x4*)(kw + half * 64 + 8 * j), w1 = *(const f32x4*)(kw + half * 64 + 8 * j + 4); v4u o;
        o.x = pk2(bflo(raw[j].x) * rs * w0[0], bfhi(raw[j].x) * rs * w0[1]); o.y = pk2(bflo(raw[j].y) * rs * w0[2], bfhi(raw[j].y) * rs * w0[3]);
        o.z = pk2(bflo(raw[j].z) * rs * w1[0], bfhi(raw[j].z) * rs * w1[1]); o.w = pk2(bflo(raw[j].w) * rs * w1[2], bfhi(raw[j].w) * rs * w1[3]);
        *(v4u*)(kp + 8 * j) = o; *(LAS v4u*)(lk + row * 128 + half * 64 + 8 * j) = o; }
    __syncthreads();
    LAS float* lp = (LAS float*)(lds + 65536);
    { const int c = tid & 127, part = tid >> 7; float s = 0.f;
#pragma unroll 8
      for (int i = 0; i < 64; ++i) s += bf1(lk[(part * 64 + i) * 128 + c]);
      lp[part * 128 + c] = s; }
    __syncthreads();
    if (tid < 128) kmean[((size_t)(b * 8 + h) * 16 + blk) * 128 + tid] = (lp[tid] + lp[128 + tid] + lp[256 + tid] + lp[384 + tid]) * (1.f / 256.f);
    __syncthreads();
}

__device__ __forceinline__ void ssd_prep_unit(const Params& P, int layer, int su, LAS unsigned char* lds) {
    const int tid = fresh_tid(), lane = tid & 63, wave = tid >> 6; const int b = su >> 6, c = (su >> 1) & 31, g = su & 1;
    const int t0 = b * SEQ + c * 128, s0 = c * 128;
    unsigned char* ws = P.ws; const bf16* PT = (const bf16*)(ws + OFF_PT); const bf16* CT = (const bf16*)(ws + OFF_CT); bf16* CC = (bf16*)(ws + OFF_CC); bf16* BMCM = (bf16*)(ws + OFF_BMCM);
    float* DTt = (float*)(ws + OFF_DT); float* ACt = (float*)(ws + OFF_ACUM); float* CDEC = (float*)(ws + OFF_CDEC); float* STATES = (float*)(ws + OFF_STATES);
    const float* cw = P.in[5] + (size_t)layer * 4 * 1536; const float* cb = P.in[6] + layer * 1536;
    LAS float* wts = (LAS float*)lds;
    { const int hd = 8 * g + wave; const int l = 2 * lane;
      const float bias = P.in[7][layer * 16 + hd]; const float a = -__expf(P.in[8][layer * 16 + hd]);
      float v0 = bf1(PT[(size_t)(t0 + l) * NPT + PT_DT + hd]) + bias, v1 = bf1(PT[(size_t)(t0 + l + 1) * NPT + PT_DT + hd]) + bias;
      const float d0 = v0 > 20.f ? v0 : log1pf(__expf(v0)), d1 = v1 > 20.f ? v1 : log1pf(__expf(v1));
      const float la0 = d0 * a, la1 = d1 * a; float x = la0 + la1;
#pragma unroll
      for (int o = 1; o < 64; o <<= 1) { const float y = __shfl_up(x, o); if (lane >= o) x += y; }
      const float ac1 = x, ac0 = x - la1; const float tot = __shfl(x, 63);
      const size_t o2 = (size_t)(b * 16 + hd) * SEQ + s0 + l;
      *(f32x2*)(DTt + o2) = (f32x2){d0, d1}; *(f32x2*)(ACt + o2) = (f32x2){ac0, ac1};
      wts[wave * 128 + l] = d0 * __expf(tot - ac0); wts[wave * 128 + l + 1] = d1 * __expf(tot - ac1);
      if (lane == 63) CDEC[(b * 32 + c) * 16 + hd] = __expf(tot); }
    for (int it = tid; it < 640 * 16; it += 512) {
        const int row = it >> 4, sg = it & 15; int ctrow, ch, ccrow;
        if (row < 512) { ctrow = 1024 + 512 * g + row; ch = 512 * g + row; ccrow = 512 * g + row; } else { ctrow = 2048 + 128 * g + (row - 512); ch = 1024 + 128 * g + (row - 512); ccrow = 1024 + 128 * g + (row - 512); }
        const bf16* src = CT + (size_t)ctrow * T + t0 + 8 * sg;
        const v4u cur = *(const v4u*)src; v4u prev = (v4u){0u, 0u, 0u, 0u}; if (s0 + 8 * sg > 0) prev = *(const v4u*)(src - 8);
        const float w0 = cw[ch], w1 = cw[1536 + ch], w2 = cw[2 * 1536 + ch], w3 = cw[3 * 1536 + ch], bi = cb[ch];
        float xv[11]; xv[0] = bfhi(prev.z); xv[1] = bflo(prev.w); xv[2] = bfhi(prev.w);
        xv[3] = bflo(cur.x); xv[4] = bfhi(cur.x); xv[5] = bflo(cur.y); xv[6] = bfhi(cur.y); xv[7] = bflo(cur.z); xv[8] = bfhi(cur.z); xv[9] = bflo(cur.w); xv[10] = bfhi(cur.w);
        float o[8];
#pragma unroll
        for (int i = 0; i < 8; ++i) o[i] = silu_f(bi + w0 * xv[i] + w1 * xv[i + 1] + w2 * xv[i + 2] + w3 * xv[i + 3]);
        v4u ov; ov.x = pk2(o[0], o[1]); ov.y = pk2(o[2], o[3]); ov.z = pk2(o[4], o[5]); ov.w = pk2(o[6], o[7]);
        *(v4u*)(CC + (size_t)ccrow * T + t0 + 8 * sg) = ov;
    }
    { const int cgp = tid & 31, run = tid >> 5; int ptcol, ch0, ocol;
      if (cgp < 16) { ptcol = PT_BM + 128 * g + 8 * cgp; ch0 = 1024 + 128 * g + 8 * cgp; ocol = 128 * g + 8 * cgp; } else { ptcol = PT_CM + 128 * g + 8 * (cgp - 16); ch0 = 1280 + 128 * g + 8 * (cgp - 16); ocol = 256 + 128 * g + 8 * (cgp - 16); }
      float w[4][8], bi[8];
#pragma unroll
      for (int k = 0; k < 4; ++k) { const f32x4 a = *(const f32x4*)(cw + k * 1536 + ch0), bq = *(const f32x4*)(cw + k * 1536 + ch0 + 4);
#pragma unroll
          for (int e = 0; e < 4; ++e) { w[k][e] = a[e]; w[k][4 + e] = bq[e]; } }
      { const f32x4 a = *(const f32x4*)(cb + ch0), bq = *(const f32x4*)(cb + ch0 + 4);
#pragma unroll
        for (int e = 0; e < 4; ++e) { bi[e] = a[e]; bi[4 + e] = bq[e]; } }
      float x1[8], x2[8], x3[8];
      const int sb = s0 + 8 * run;
#define HALO_ROW(k, d) do { v4u r_ = (v4u){0u, 0u, 0u, 0u}; if (sb - (k) >= 0) r_ = *(const v4u*)(PT + (size_t)(t0 + 8 * run - (k)) * NPT + ptcol); \
          _Pragma("unroll") for (int e = 0; e < 4; ++e) { d[2 * e] = bflo(r_[e]); d[2 * e + 1] = bfhi(r_[e]); } } while (0)
      HALO_ROW(1, x1); HALO_ROW(2, x2); HALO_ROW(3, x3);
#undef HALO_ROW
#pragma unroll
      for (int i = 0; i < 8; ++i) { const v4u r = *(const v4u*)(PT + (size_t)(t0 + 8 * run + i) * NPT + ptcol); float x0[8], o[8];
#pragma unroll
          for (int e = 0; e < 4; ++e) { x0[2 * e] = bflo(r[e]); x0[2 * e + 1] = bfhi(r[e]); }
#pragma unroll
          for (int e = 0; e < 8; ++e) { o[e] = silu_f(bi[e] + w[0][e] * x3[e] + w[1][e] * x2[e] + w[2][e] * x1[e] + w[3][e] * x0[e]); x3[e] = x2[e]; x2[e] = x1[e]; x1[e] = x0[e]; }
          v4u ov; ov.x = pk2(o[0], o[1]); ov.y = pk2(o[2], o[3]); ov.z = pk2(o[4], o[5]); ov.w = pk2(o[6], o[7]);
          *(v4u*)(BMCM + (size_t)(t0 + 8 * run + i) * 512 + ocol) = ov; } }
    __syncthreads();
    { const int hd = 8 * g + wave, i16 = lane & 15, quad = lane >> 4;
      bf16x8 Af[4][4];
#pragma unroll
      for (int pt = 0; pt < 4; ++pt)
#pragma unroll
          for (int ls = 0; ls < 4; ++ls) { const v4u r = *(const v4u*)(CC + (size_t)(512 * g + 64 * wave + 16 * pt + i16) * T + t0 + 32 * ls + 8 * quad);
              const LAS float* wp = wts + wave * 128 + 32 * ls + 8 * quad; v4u o;
              o.x = pk2(bflo(r.x) * wp[0], bfhi(r.x) * wp[1]); o.y = pk2(bflo(r.y) * wp[2], bfhi(r.y) * wp[3]); o.z = pk2(bflo(r.z) * wp[4], bfhi(r.z) * wp[5]); o.w = pk2(bflo(r.w) * wp[6], bfhi(r.w) * wp[7]);
              Af[pt][ls] = __builtin_bit_cast(bf16x8, o); }
      float* st = STATES + (size_t)((b * 32 + c) * 16 + hd) * 8192;
#pragma unroll 1
      for (int nt = 0; nt < 8; ++nt) { bf16x8 Bf[4];
#pragma unroll
          for (int ls = 0; ls < 4; ++ls) Bf[ls] = *(const bf16x8*)(CC + (size_t)(1024 + 128 * g + 16 * nt + i16) * T + t0 + 32 * ls + 8 * quad);
#pragma unroll
          for (int pt = 0; pt < 4; ++pt) { f32x4 acc = (f32x4){0.f, 0.f, 0.f, 0.f};
#pragma unroll
              for (int ls = 0; ls < 4; ++ls) acc = MFMA16(Af[pt][ls], Bf[ls], acc);
#pragma unroll
              for (int r = 0; r < 4; ++r) st[(16 * pt + 4 * quad + r) * 128 + 16 * nt + i16] = acc[r]; } } }
    __syncthreads();
}

__device__ __forceinline__ void scan_phase(const Params& P) {
    const float* STATES = (const float*)(P.ws + OFF_STATES); const float* CDEC = (const float*)(P.ws + OFF_CDEC); bf16* HIN = (bf16*)(P.ws + OFF_HIN);
    const int gt = fresh_bid() * 512 + fresh_tid(), NT = gridDim.x * 512;
    for (int item = gt; item < 64 * 2048; item += NT) { const int bh = item >> 11, e4 = (item & 2047) * 4; const int b = bh >> 4, hd = bh & 15;
        f32x4 h = (f32x4){0.f, 0.f, 0.f, 0.f};
#pragma unroll 4
        for (int c = 0; c < 32; ++c) { const size_t base = (size_t)((b * 32 + c) * 16 + hd) * 8192 + e4;
            v2u o; o.x = pk2(h[0], h[1]); o.y = pk2(h[2], h[3]); *(v2u*)(HIN + base) = o;
            const float dec = CDEC[(b * 32 + c) * 16 + hd]; const f32x4 st = *(const f32x4*)(STATES + base); h = h * dec + st; } }
}

__device__ __forceinline__ void attn_unit(const Params& P, int layer, int b, int h, int i, LAS unsigned char* lds) {
    const int tid = fresh_tid(), lane = tid & 63, w = tid >> 6, i16 = lane & 15, quad = lane >> 4;
    unsigned char* ws = P.ws; const bf16* PT = (const bf16*)(ws + OFF_PT); const bf16* CT = (const bf16*)(ws + OFF_CT); bf16* MIX = (bf16*)(ws + OFF_MIX); const float* kmean = (const float*)(ws + OFF_KMEAN);
    const float* qw = P.in[3] + layer * 128; const float* kw = P.in[4] + layer * 128;
    const float mq = wave_max(fmaxf(fabsf(qw[lane]), fabsf(qw[lane + 64]))), mk = wave_max(fmaxf(fabsf(kw[lane]), fabsf(kw[lane + 64])));
    const float C2 = 0.08838834764831845f * 1.4426950408889634f; const float Bnd = C2 * 128.f * mq * mk;
    float qf[2][32]; unsigned selmask[2];
#pragma unroll
    for (int qt = 0; qt < 2; ++qt) { const int t = b * SEQ + 256 * i + 32 * w + 16 * qt + i16; const bf16* qp = PT + (size_t)t * NPT + PT_Q + h * 128 + 8 * quad; float ss = 0.f;
#pragma unroll
        for (int s = 0; s < 4; ++s) { const v4u r = *(const v4u*)(qp + 32 * s);
#pragma unroll
            for (int e = 0; e < 4; ++e) { const float a = bflo(r[e]), c = bfhi(r[e]); qf[qt][8 * s + 2 * e] = a; qf[qt][8 * s + 2 * e + 1] = c; ss += a * a + c * c; } }
        ss += __shfl_xor(ss, 16); ss += __shfl_xor(ss, 32);
        const float rs = __builtin_amdgcn_rsqf(ss * (1.f / 128.f) + EPS);
#pragma unroll
        for (int s = 0; s < 4; ++s) { const f32x4 w0 = *(const f32x4*)(qw + 32 * s + 8 * quad), w1 = *(const f32x4*)(qw + 32 * s + 8 * quad + 4);
#pragma unroll
            for (int e = 0; e < 4; ++e) { qf[qt][8 * s + e] *= rs * w0[e]; qf[qt][8 * s + 4 + e] *= rs * w1[e]; } } }
    { float g0[16], g1[16];
#pragma unroll
      for (int j = 0; j < 16; ++j) { g0[j] = 0.f; g1[j] = 0.f;
          if (j < i) { const float* km = kmean + ((size_t)(b * 8 + h) * 16 + j) * 128 + 8 * quad; float p0 = 0.f, p1 = 0.f;
#pragma unroll
              for (int s = 0; s < 4; ++s) { const f32x4 k0 = *(const f32x4*)(km + 32 * s), k1 = *(const f32x4*)(km + 32 * s + 4);
#pragma unroll
                  for (int e = 0; e < 4; ++e) { p0 += qf[0][8 * s + e] * k0[e] + qf[0][8 * s + 4 + e] * k1[e]; p1 += qf[1][8 * s + e] * k0[e] + qf[1][8 * s + 4 + e] * k1[e]; } }
              p0 += __shfl_xor(p0, 16); p0 += __shfl_xor(p0, 32); p1 += __shfl_xor(p1, 16); p1 += __shfl_xor(p1, 32); g0[j] = p0; g1[j] = p1; } }
      unsigned m0 = 0u, m1 = 0u;
#pragma unroll
      for (int r = 0; r < 3; ++r) { float b0 = -INFINITY, b1 = -INFINITY; int i0 = -1, i1 = -1;
#pragma unroll
          for (int j = 0; j < 16; ++j) { if (j < i) { if (!((m0 >> j) & 1u) && g0[j] > b0) { b0 = g0[j]; i0 = j; } if (!((m1 >> j) & 1u) && g1[j] > b1) { b1 = g1[j]; i1 = j; } } }
          if (i0 >= 0) m0 |= 1u << i0; if (i1 >= 0) m1 |= 1u << i1; }
      selmask[0] = m0; selmask[1] = m1; }
    bf16x8 Qf[2][4];
#pragma unroll
    for (int qt = 0; qt < 2; ++qt)
#pragma unroll
        for (int s = 0; s < 4; ++s) { v4u o;
            o.x = pk2(qf[qt][8 * s + 0] * C2, qf[qt][8 * s + 1] * C2); o.y = pk2(qf[qt][8 * s + 2] * C2, qf[qt][8 * s + 3] * C2);
            o.z = pk2(qf[qt][8 * s + 4] * C2, qf[qt][8 * s + 5] * C2); o.w = pk2(qf[qt][8 * s + 6] * C2, qf[qt][8 * s + 7] * C2);
            Qf[qt][s] = __builtin_bit_cast(bf16x8, o); }
    unsigned wsel = selmask[0] | selmask[1];
#pragma unroll
    for (int o = 1; o < 64; o <<= 1) wsel |= (unsigned)__shfl_xor((int)wsel, o);
    f32x4 O[2][8]; float lsum[2] = {0.f, 0.f};
#pragma unroll
    for (int qt = 0; qt < 2; ++qt)
#pragma unroll
        for (int dt = 0; dt < 8; ++dt) O[qt][dt] = (f32x4){0.f, 0.f, 0.f, 0.f};
    const int ntiles = (i + 1) * 4;
    v4u kr[2], vr[2];
#define ATT_LOAD(n) do { const int _j = (n) >> 2, _kt = (n) & 3; const int _tk = b * SEQ + 256 * _j + 64 * _kt; \
        _Pragma("unroll") for (int _c = 0; _c < 2; ++_c) { const int cid = tid + 512 * _c; \
            kr[_c] = *(const v4u*)(PT + (size_t)(_tk + (cid >> 4)) * NPT + PT_K + h * 128 + 8 * (cid & 15)); \
            vr[_c] = *(const v4u*)(CT + (size_t)(h * 128 + (cid >> 3)) * T + _tk + 8 * (cid & 7)); } } while (0)
#define ATT_STORE(buf) do { LAS unsigned char* _kb = lds + (buf) * 32768; LAS unsigned char* _vb = _kb + 16384; \
        _Pragma("unroll") for (int _c = 0; _c < 2; ++_c) { const int cid = tid + 512 * _c; const int kr_ = cid >> 4, kc_ = cid & 15, vd_ = cid >> 3, vc_ = cid & 7; \
            *(LAS v4u*)(_kb + kr_ * 256 + 16 * (kc_ ^ ((kr_ & 3) | (((kr_ >> 3) & 3) << 2)))) = kr[_c]; \
            *(LAS v4u*)(_vb + vd_ * 128 + 16 * (vc_ ^ ((vd_ >> 1) & 7))) = vr[_c]; } } while (0)
    ATT_LOAD(0); ATT_STORE(0); __syncthreads();
#pragma unroll 1
    for (int n = 0; n < ntiles; ++n) {
        const int cur = n & 1; const int j = n >> 2, kt = n & 3; const bool own = (j == i);
        if (n + 1 < ntiles) ATT_LOAD(n + 1);
        const bool active = own ? (64 * kt <= 32 * w + 31) : (((wsel >> j) & 1u) != 0u);
        if (active) {
            const LAS unsigned char* kb = lds + cur * 32768; const LAS unsigned char* vb = kb + 16384;
#pragma unroll
            for (int kk = 0; kk < 2; ++kk) {
                const int rka = 32 * kk + 8 * (i16 >> 2) + (i16 & 3);
                bf16x8 Pf[2];
                { bf16x8 Ka[4], Kb[4];
#pragma unroll
                  for (int s = 0; s < 4; ++s) { Ka[s] = *(const LAS bf16x8*)(kb + rka * 256 + 16 * ((4 * s + quad) ^ i16)); Kb[s] = *(const LAS bf16x8*)(kb + (rka + 4) * 256 + 16 * ((4 * s + quad) ^ i16)); }
#pragma unroll
                  for (int qt = 0; qt < 2; ++qt) {
                    f32x4 Sa = (f32x4){0.f, 0.f, 0.f, 0.f}, Sb = (f32x4){0.f, 0.f, 0.f, 0.f};
#pragma unroll
                    for (int s = 0; s < 4; ++s) { Sa = MFMA16(Ka[s], Qf[qt][s], Sa); Sb = MFMA16(Kb[s], Qf[qt][s], Sb); }
                    float pa[4], pb[4]; const int qpos = 32 * w + 16 * qt + i16; const int kbase = 64 * kt + 32 * kk + 8 * quad; const bool selj = ((selmask[qt] >> j) & 1u) != 0u;
#pragma unroll
                    for (int r = 0; r < 4; ++r) { const bool va = own ? (kbase + r <= qpos) : selj, vb2 = own ? (kbase + 4 + r <= qpos) : selj;
                        pa[r] = va ? __builtin_amdgcn_exp2f(Sa[r] - Bnd) : 0.f; pb[r] = vb2 ? __builtin_amdgcn_exp2f(Sb[r] - Bnd) : 0.f; }
                    lsum[qt] += (pa[0] + pa[1]) + (pa[2] + pa[3]) + (pb[0] + pb[1]) + (pb[2] + pb[3]);
                    v4u pk; pk.x = pk2(pa[0], pa[1]); pk.y = pk2(pa[2], pa[3]); pk.z = pk2(pb[0], pb[1]); pk.w = pk2(pb[2], pb[3]);
                    Pf[qt] = __builtin_bit_cast(bf16x8, pk);
                  } }
#pragma unroll
                for (int dh = 0; dh < 2; ++dh) { bf16x8 Vf[4];
#pragma unroll
                    for (int d4 = 0; d4 < 4; ++d4) { const int d = 16 * (4 * dh + d4) + i16; Vf[d4] = *(const LAS bf16x8*)(vb + d * 128 + 16 * ((4 * kk + quad) ^ ((d >> 1) & 7))); }
#pragma unroll
                    for (int qt = 0; qt < 2; ++qt)
#pragma unroll
                        for (int d4 = 0; d4 < 4; ++d4) O[qt][4 * dh + d4] = MFMA16(Vf[d4], Pf[qt], O[qt][4 * dh + d4]);
                    asm volatile("" ::: "memory"); }
            }
        }
        if (n + 1 < ntiles) ATT_STORE(cur ^ 1);
        __syncthreads();
    }
#undef ATT_LOAD
#undef ATT_STORE
#pragma unroll
    for (int qt = 0; qt < 2; ++qt) { float l = lsum[qt]; l += __shfl_xor(l, 16); l += __shfl_xor(l, 32); const float inv = 1.f / l;
        const int t = b * SEQ + 256 * i + 32 * w + 16 * qt + i16; bf16* op = MIX + (size_t)t * DM + h * 128 + 4 * quad;
#pragma unroll
        for (int dt = 0; dt < 8; ++dt) { v2u o; o.x = pk2(O[qt][dt][0] * inv, O[qt][dt][1] * inv); o.y = pk2(O[qt][dt][2] * inv, O[qt][dt][3] * inv); *(v2u*)(op + 16 * dt) = o; } }
}

__device__ __forceinline__ void ssd_out_unit(const Params& P, int layer, int su) {
    const int tid = fresh_tid(), lane = tid & 63, w = tid >> 6, i16 = lane & 15, quad = lane >> 4; const int b = su >> 6, c = (su >> 1) & 31, g = su & 1;
    const int t0 = b * SEQ + c * 128, s0 = c * 128; const int lq = 16 * w + i16; const int t = t0 + lq;
    unsigned char* ws = P.ws; const bf16* PT = (const bf16*)(ws + OFF_PT); const bf16* CC = (const bf16*)(ws + OFF_CC); const bf16* BMCM = (const bf16*)(ws + OFF_BMCM); bf16* MIX = (bf16*)(ws + OFF_MIX);
    const float* DTt = (const float*)(ws + OFF_DT); const float* ACt = (const float*)(ws + OFF_ACUM); const bf16* HIN = (const bf16*)(ws + OFF_HIN);
    const float* dskip = P.in[9] + layer * 16; const float* nw = P.in[10] + layer * 1024;
    bf16x8 Bcm[4];
#pragma unroll
    for (int ns = 0; ns < 4; ++ns) Bcm[ns] = *(const bf16x8*)(BMCM + (size_t)t * 512 + 256 + 128 * g + 32 * ns + 8 * quad);
    const int nss = (w >> 1) + 1;
    f32x4 CBa[4], CBb[4];
#pragma unroll
    for (int ss = 0; ss < 4; ++ss) { CBa[ss] = (f32x4){0.f, 0.f, 0.f, 0.f}; CBb[ss] = (f32x4){0.f, 0.f, 0.f, 0.f};
        if (ss < nss) { const int sa = 32 * ss + 8 * (i16 >> 2) + (i16 & 3);
#pragma unroll
            for (int ns = 0; ns < 4; ++ns) { const bf16x8 Aa = *(const bf16x8*)(BMCM + (size_t)(t0 + sa) * 512 + 128 * g + 32 * ns + 8 * quad), Ab = *(const bf16x8*)(BMCM + (size_t)(t0 + sa + 4) * 512 + 128 * g + 32 * ns + 8 * quad);
                CBa[ss] = MFMA16(Aa, Bcm[ns], CBa[ss]); CBb[ss] = MFMA16(Ab, Bcm[ns], CBb[ss]); } } }
    float ssq = 0.f;
#pragma unroll 1
    for (int r = 0; r < 8; ++r) { const int hd = 8 * g + r; const size_t hoff = (size_t)(b * 16 + hd) * SEQ + s0;
        const float al = ACt[hoff + lq]; const float el = __expf(al);
        f32x4 yd[4], yo[4];
#pragma unroll
        for (int pt = 0; pt < 4; ++pt) { yd[pt] = (f32x4){0.f, 0.f, 0.f, 0.f}; yo[pt] = (f32x4){0.f, 0.f, 0.f, 0.f}; }
#pragma unroll
        for (int ss = 0; ss < 4; ++ss) { if (ss < nss) { const int sb = 32 * ss + 8 * quad;
                const f32x4 a0 = *(const f32x4*)(ACt + hoff + sb), a1 = *(const f32x4*)(ACt + hoff + sb + 4), d0 = *(const f32x4*)(DTt + hoff + sb), d1 = *(const f32x4*)(DTt + hoff + sb + 4);
                float m[8];
#pragma unroll
                for (int e = 0; e < 4; ++e) { m[e] = (sb + e <= lq) ? CBa[ss][e] * __expf(al - a0[e]) * d0[e] : 0.f; m[4 + e] = (sb + 4 + e <= lq) ? CBb[ss][e] * __expf(al - a1[e]) * d1[e] : 0.f; }
                v4u pk; pk.x = pk2(m[0], m[1]); pk.y = pk2(m[2], m[3]); pk.z = pk2(m[4], m[5]); pk.w = pk2(m[6], m[7]); const bf16x8 Bm = __builtin_bit_cast(bf16x8, pk);
#pragma unroll
                for (int pt = 0; pt < 4; ++pt) { const bf16x8 Ax = *(const bf16x8*)(CC + (size_t)(512 * g + 64 * r + 16 * pt + i16) * T + t0 + sb); yd[pt] = MFMA16(Ax, Bm, yd[pt]); } } }
        const bf16* hp = HIN + (size_t)((b * 32 + c) * 16 + hd) * 8192;
#pragma unroll
        for (int pt = 0; pt < 4; ++pt)
#pragma unroll
            for (int ns = 0; ns < 4; ++ns) { const bf16x8 Ah = *(const bf16x8*)(hp + (16 * pt + i16) * 128 + 32 * ns + 8 * quad); yo[pt] = MFMA16(Ah, Bcm[ns], yo[pt]); }
        const float dsk = dskip[hd];
#pragma unroll
        for (int pt = 0; pt < 4; ++pt) { const int p0 = 16 * pt + 4 * quad; const int chn = 512 * g + 64 * r + p0;
            const v2u zr = *(const v2u*)(PT + (size_t)t * NPT + PT_Z + chn); const float z[4] = {bflo(zr.x), bfhi(zr.x), bflo(zr.y), bfhi(zr.y)}; float v[4];
#pragma unroll
            for (int e = 0; e < 4; ++e) { const float xs = bf1(CC[(size_t)(chn + e) * T + t]); const float y = yd[pt][e] + yo[pt][e] * el + dsk * xs; v[e] = y * silu_f(z[e]); ssq += v[e] * v[e]; }
            v2u o; o.x = pk2(v[0], v[1]); o.y = pk2(v[2], v[3]); *(v2u*)(MIX + (size_t)t * DM + 1024 + chn) = o; } }
    ssq += __shfl_xor(ssq, 16); ssq += __shfl_xor(ssq, 32);
    const float rs = __builtin_amdgcn_rsqf(ssq * (1.f / 512.f) + EPS);
#pragma unroll 1
    for (int r = 0; r < 8; ++r)
#pragma unroll
        for (int pt = 0; pt < 4; ++pt) { const int chn = 512 * g + 64 * r + 16 * pt + 4 * quad; bf16* mp = MIX + (size_t)t * DM + 1024 + chn;
            const v2u vr = *(const v2u*)mp; const f32x4 wv = *(const f32x4*)(nw + chn);
            v2u o; o.x = pk2(bflo(vr.x) * rs * wv[0], bfhi(vr.x) * rs * wv[1]); o.y = pk2(bflo(vr.y) * rs * wv[2], bfhi(vr.y) * rs * wv[3]); *(v2u*)mp = o; }
}

__device__ __forceinline__ void ffn_conv_phase(const Params& P, int layer) {
    const bf16* U = (const bf16*)(P.ws + OFF_U); bf16* G = (bf16*)(P.ws + OFF_G);
    const float* cw = P.in[14] + (size_t)layer * 3 * NUP; const float* cb = P.in[15] + (size_t)layer * NUP;
    const int gt = fresh_bid() * 512 + fresh_tid(), NT = gridDim.x * 512;
    constexpr int NFG = DFF / 8, RUN = 32, NITEM = (T / RUN) * NFG;
    for (int item = gt; item < NITEM; item += NT) { const int tr = item / NFG, fg = item - tr * NFG; const int f0 = 8 * fg; const int tb = tr * RUN; const int sb = tb & (SEQ - 1);
        float wg[3][8], wv[3][8], bg[8], bv[8];
#pragma unroll
        for (int k = 0; k < 3; ++k) { const f32x4 a = *(const f32x4*)(cw + (size_t)k * NUP + f0), a2 = *(const f32x4*)(cw + (size_t)k * NUP + f0 + 4), c = *(const f32x4*)(cw + (size_t)k * NUP + DFF + f0), c2 = *(const f32x4*)(cw + (size_t)k * NUP + DFF + f0 + 4);
#pragma unroll
            for (int e = 0; e < 4; ++e) { wg[k][e] = a[e]; wg[k][4 + e] = a2[e]; wv[k][e] = c[e]; wv[k][4 + e] = c2[e]; } }
        { const f32x4 a = *(const f32x4*)(cb + f0), a2 = *(const f32x4*)(cb + f0 + 4), c = *(const f32x4*)(cb + DFF + f0), c2 = *(const f32x4*)(cb + DFF + f0 + 4);
#pragma unroll
          for (int e = 0; e < 4; ++e) { bg[e] = a[e]; bg[4 + e] = a2[e]; bv[e] = c[e]; bv[4 + e] = c2[e]; } }
        float g1[8], g2[8], v1[8], v2[8];
#define HALO_ROW(k, dg, dv) do { v4u rg_ = (v4u){0u, 0u, 0u, 0u}, rv_ = (v4u){0u, 0u, 0u, 0u}; \
            if (sb - (k) >= 0) { rg_ = *(const v4u*)(U + (size_t)(tb - (k)) * NUP + f0); rv_ = *(const v4u*)(U + (size_t)(tb - (k)) * NUP + DFF + f0); } \
            _Pragma("unroll") for (int e = 0; e < 4; ++e) { dg[2 * e] = bflo(rg_[e]); dg[2 * e + 1] = bfhi(rg_[e]); dv[2 * e] = bflo(rv_[e]); dv[2 * e + 1] = bfhi(rv_[e]); } } while (0)
        HALO_ROW(1, g1, v1); HALO_ROW(2, g2, v2);
#undef HALO_ROW
#pragma unroll 4
        for (int i = 0; i < RUN; ++i) { const v4u rg = *(const v4u*)(U + (size_t)(tb + i) * NUP + f0), rv = *(const v4u*)(U + (size_t)(tb + i) * NUP + DFF + f0); float g0[8], v0[8], o[8];
#pragma unroll
            for (int e = 0; e < 4; ++e) { g0[2 * e] = bflo(rg[e]); g0[2 * e + 1] = bfhi(rg[e]); v0[2 * e] = bflo(rv[e]); v0[2 * e + 1] = bfhi(rv[e]); }
#pragma unroll
            for (int e = 0; e < 8; ++e) { const float ug = bg[e] + wg[0][e] * g2[e] + wg[1][e] * g1[e] + wg[2][e] * g0[e]; const float uv = bv[e] + wv[0][e] * v2[e] + wv[1][e] * v1[e] + wv[2][e] * v0[e];
                o[e] = silu_f(ug) * uv; g2[e] = g1[e]; g1[e] = g0[e]; v2[e] = v1[e]; v1[e] = v0[e]; }
            v4u ov; ov.x = pk2(o[0], o[1]); ov.y = pk2(o[2], o[3]); ov.z = pk2(o[4], o[5]); ov.w = pk2(o[6], o[7]);
            *(v4u*)(G + (size_t)(tb + i) * DFF + f0) = ov; } }
}

__global__ void __launch_bounds__(512, 2) hymba_fwd(Params P) {
    extern __shared__ __attribute__((aligned(16))) unsigned char lds[];
    cg::grid_group grid = cg::this_grid();
    const int G = gridDim.x, bx = blockIdx.x;
    unsigned char* ws = P.ws;
    LAS unsigned char* llds = (LAS unsigned char*)lds;
    if (threadIdx.x < 2) ((volatile LAS unsigned*)(llds + 131072 + 8192))[threadIdx.x] = 0u;
    __syncthreads();
    const XcdBarrier xbar = xcd_barrier_post((unsigned*)(ws + OFF_CTL), (volatile LAS unsigned*)(llds + 131072 + 8192));
    if (ws == nullptr) grid.sync();
    PG8_LAS unsigned char* glds = (PG8_LAS unsigned char*)lds;
    bf16* XB = (bf16*)(ws + OFF_XB); float* SS = (float*)(ws + OFF_SS);

    phase_x0(P);
    for (int dd = 0; dd < DUP_CONV; ++dd) convert_jobs(P, 0, 0, 8, llds);
    GSYNC();
#pragma unroll 1
    for (int L = 0; L < 2; ++L) {
        { pg8::Gemm g{XB, (const bf16*)(ws + OFF_WB), (const bf16*)(ws + OFF_WA), XB, DM};
          pg8::DualOrder S{T / 256, NPT / 256, NCT / 256, T / 256, G, bx};
          pg8::EpiScale E{(bf16*)(ws + OFF_PT), NPT, (bf16*)(ws + OFF_CT), T, SS + (2 * L) * T, 1.f / DM};
          pg8::gemm_phase<pg8::EpiScale, pg8::DualOrder, true, true>(glds, g, S, E); }
        GSYNC();
#ifndef NO_PREP
        for (int dd = 0; dd < DUP_MISC; ++dd) for (int u = bx; u < 256; u += G) ssd_prep_unit(P, L, u, llds);
#endif
#ifndef NO_KNORM
        for (int u = bx; u < 512; u += G) knorm_unit(P, L, u, llds);
#endif
        if (L == 1) for (int dd = 0; dd < DUP_CONV; ++dd) convert_jobs(P, 1, 7, 8, llds);
        GSYNC();
        for (int dd = 0; dd < DUP_MISC; ++dd) scan_phase(P);
#ifndef NO_ATTN
        for (int u = bx; u < 256; u += G) { const int bh = u >> 3, pi = u & 7;
#pragma unroll 1
            for (int rep = 0; rep < 2 * DUP_ATTN; ++rep) attn_unit(P, L, bh >> 3, bh & 7, (rep & 1) ? pi : 15 - pi, llds); }
#endif
        GSYNC();
#ifndef NO_SSDOUT
        for (int dd = 0; dd < DUP_MISC; ++dd) for (int u = bx; u < 256; u += G) ssd_out_unit(P, L, u);
#endif
        GSYNC();
        { pg8::Gemm g{(const bf16*)(ws + OFF_MIX), nullptr, (const bf16*)(ws + OFF_WOUT), nullptr, DM};
          pg8::DualOrder S{T / 256, DM / 256, 0, 0, G, bx};
          pg8::EpiResid E{L == 0 ? P.in[0] : P.out, P.out, XB, SS + (2 * L + 1) * T};
          pg8::gemm_phase<pg8::EpiResid, pg8::DualOrder, true, true>(glds, g, S, E); }
        GSYNC();
        { pg8::Gemm g{XB, nullptr, (const bf16*)(ws + OFF_WUP), nullptr, DM};
          pg8::DualOrder S{T / 256, NUP / 256, 0, 0, G, bx};
          pg8::EpiScale E{(bf16*)(ws + OFF_U), NUP, nullptr, 0, SS + (2 * L + 1) * T, 1.f / DM};
          pg8::gemm_phase<pg8::EpiScale, pg8::DualOrder, true, true>(glds, g, S, E);
#ifdef DUP_UP
          pg8::gemm_phase<pg8::EpiScale, pg8::DualOrder, true, true>(glds, g, S, E);
#endif
        }
        GSYNC();
#ifndef NO_FFNCONV
        for (int dd = 0; dd < DUP_MISC; ++dd) ffn_conv_phase(P, L);
#endif
        if (L == 0) for (int dd = 0; dd < DUP_CONV; ++dd) convert_jobs(P, 1, 0, 7, llds);
        GSYNC();
        { pg8::Gemm g{(const bf16*)(ws + OFF_G), nullptr, (const bf16*)(ws + OFF_WDOWN), nullptr, DFF};
          pg8::DualOrder S{T / 256, DM / 256, 0, 0, G, bx};
          pg8::EpiResid E{P.out, P.out, XB, L == 0 ? SS + 2 * T : nullptr};
          pg8::gemm_phase<pg8::EpiResid, pg8::DualOrder, true, true>(glds, g, S, E); }
        if (L == 0) GSYNC();
    }
}

extern "C" void kernel_launch(void* const* d_in, const int* in_sizes, int n_in, void* d_out, int out_size, void* d_ws, size_t ws_size, hipStream_t stream) {
    static int grid = 0;
    if (grid == 0) {
        if (n_in != 17 || in_sizes[0] != T * DM || out_size != T * DM || ws_size < WS_NEED) { fprintf(stderr, "kernel_launch: unexpected shapes / workspace (n_in %d, ws %zu, need %zu)\n", n_in, ws_size, (size_t)WS_NEED); grid = -1; return; }
        int dev = 0, cus = 0, per_cu = 0;
        hipGetDevice(&dev); hipDeviceGetAttribute(&cus, hipDeviceAttributeMultiprocessorCount, dev);
        if (hipFuncSetAttribute((const void*)hymba_fwd, hipFuncAttributeMaxDynamicSharedMemorySize, LDS_BYTES) != hipSuccess) { fprintf(stderr, "kernel_launch: hipFuncSetAttribute failed\n"); grid = -1; return; }
        if (hipOccupancyMaxActiveBlocksPerMultiprocessor(&per_cu, (const void*)hymba_fwd, 512, LDS_BYTES) != hipSuccess || per_cu < 1) { fprintf(stderr, "kernel_launch: occupancy query gave %d\n", per_cu); per_cu = 1; }
        (void)hipGetLastError();
        grid = cus * 1;
        if (grid <= 0) grid = 256;
    }
    if (grid < 0) return;
    Params p{};
    for (int i = 0; i < 17; ++i) p.in[i] = (const float*)d_in[i];
    p.out = (float*)d_out; p.ws = (unsigned char*)d_ws;
    if (hipMemsetAsync((char*)d_ws + OFF_CTL, 0, 16384, stream) != hipSuccess) { fprintf(stderr, "kernel_launch: memset failed\n"); return; }
    void* args[] = {&p};
    hipError_t e = hipLaunchCooperativeKernel((const void*)hymba_fwd, dim3(grid), dim3(512), args, LDS_BYTES, stream);
    if (e != hipSuccess) fprintf(stderr, "cooperative launch failed: %s (grid %d)\n", hipGetErrorString(e), grid);
}
```
